# Optimizing an MI355X kernel written in HIP

```python
import jax, jax.numpy as jnp
from jax import lax
import numpy as np

D_MODEL = 1024
BATCH = 4
SEQ = 4096
DEPTH = 4
DEC_BATCH = 8
DEC_SEQ = 8192
PAST_LEN = 128

CONV_CH = D_MODEL // 4
CONV_W = 3
N_HEADS = 8
N_KV_HEADS = 2
HEAD_DIM = D_MODEL // 16
WINDOW = 128
BLOCK = 128
DN_HEADS = 4
DN_DIM = D_MODEL // 16
DN_CONV_W = 3
CHUNK = 64
D_FF = 4 * D_MODEL
ATT_Q = N_HEADS * HEAD_DIM
ATT_KV = N_KV_HEADS * HEAD_DIM
DN_W = DN_HEADS * DN_DIM
D_MIX = CONV_CH + ATT_Q + DN_W
OFF_ATT = 3 * CONV_CH
OFF_DN = OFF_ATT + ATT_Q + 2 * ATT_KV
D_IN = OFF_DN + 4 * DN_W + 4 * DN_HEADS
ALPHA = (2.0 * DEPTH) ** 0.25
BETA_INIT = (8.0 * DEPTH) ** -0.25
LN_EPS = 1e-5
RMS_EPS = 1e-6

kernel_name = 'hybrid_bidir_conv_swa_gdn_encoder'


def layer_norm(x, g, b):
    xf = x.astype(jnp.float32)
    mu = jnp.mean(xf, -1, keepdims=True)
    var = jnp.mean(jnp.square(xf - mu), -1, keepdims=True)
    y = (xf - mu) * lax.rsqrt(var + LN_EPS) * g.astype(jnp.float32) + b.astype(jnp.float32)
    return y.astype(x.dtype)


def modulate(x, shift, scale):
    return x * (1 + scale[:, None, :]) + shift[:, None, :]


def dwconv_centred(x, w):
    p = w.shape[0] // 2
    return lax.conv_general_dilated(x, w[:, None, :].astype(x.dtype), (1,), ((p, p),),
                                    dimension_numbers=('NWC', 'WIO', 'NWC'),
                                    feature_group_count=x.shape[-1])


def short_conv_mixer(p, conv_w):
    b_gate, c_gate, u = jnp.split(p, 3, axis=-1)
    return b_gate * dwconv_centred(c_gate * u, conv_w)


def window_attention(q, k, v, sink):
    bsz, s, _ = q.shape
    nb = s // BLOCK
    grp = N_HEADS // N_KV_HEADS
    qb = q.reshape(bsz, nb, BLOCK, N_KV_HEADS, grp, HEAD_DIM)

    def neighbours(t):
        tp = jnp.pad(t.reshape(bsz, s, N_KV_HEADS, HEAD_DIM), ((0, 0), (BLOCK, BLOCK), (0, 0), (0, 0)))
        tp = tp.reshape(bsz, nb + 2, BLOCK, N_KV_HEADS, HEAD_DIM)
        return jnp.concatenate([tp[:, :-2], tp[:, 1:-1], tp[:, 2:]], axis=2)

    kb, vb = neighbours(k), neighbours(v)
    scores = jnp.einsum('bnqhgd,bnkhd->bnhgqk', qb, kb).astype(jnp.float32) * HEAD_DIM ** -0.5
    rel = jnp.arange(3 * BLOCK)[None, :] - BLOCK - jnp.arange(BLOCK)[:, None]
    dist = jnp.abs(rel).astype(jnp.float32)
    key_pos = (jnp.arange(nb)[:, None] - 1) * BLOCK + jnp.arange(3 * BLOCK)[None, :]
    valid = (jnp.abs(rel) <= WINDOW)[None] & ((key_pos >= 0) & (key_pos < s))[:, None, :]
    slopes = jnp.exp2(-8.0 * jnp.arange(1, N_HEADS + 1, dtype=jnp.float32) / N_HEADS).reshape(N_KV_HEADS, grp)
    scores = scores - slopes[:, :, None, None] * dist
    scores = jnp.where(valid[:, None, None], scores, -jnp.inf)
    sink_l = sink.astype(jnp.float32).reshape(N_KV_HEADS, grp)[:, :, None, None]
    m = jnp.maximum(jnp.max(scores, -1, keepdims=True), sink_l)
    e = jnp.exp(scores - m)
    denom = jnp.sum(e, -1, keepdims=True) + jnp.exp(sink_l - m)
    probs = (e / denom).astype(v.dtype)
    o = jnp.einsum('bnhgqk,bnkhd->bnqhgd', probs, vb)
    return o.reshape(bsz, s, ATT_Q)


def gated_delta_chunked(q, k, v, g, beta):
    bsz, s, h, dk = q.shape
    n = s // CHUNK

    def chunks(t):
        return jnp.moveaxis(t.reshape(bsz, n, CHUNK, h, *t.shape[3:]), 3, 1)

    q, k, v, g, beta = (chunks(t) for t in (q, k, v, g, beta))
    q = q * dk ** -0.5
    gc = jnp.cumsum(g, axis=-1)
    idx = jnp.arange(CHUNK)
    causal = idx[:, None] >= idx[None, :]
    strict = idx[:, None] > idx[None, :]
    decay = jnp.exp(jnp.where(causal, gc[..., :, None] - gc[..., None, :], -jnp.inf))
    k_beta = k * beta[..., None]
    lower = jnp.where(strict, jnp.einsum('bhncd,bhnsd->bhncs', k_beta, k) * decay, 0.0)
    tmat = lower + jnp.eye(CHUNK, dtype=lower.dtype)
    u = lax.linalg.triangular_solve(tmat, v * beta[..., None], left_side=True, lower=True)
    w = lax.linalg.triangular_solve(tmat, k_beta * jnp.exp(gc)[..., None], left_side=True, lower=True)
    a_intra = jnp.where(causal, jnp.einsum('bhncd,bhnsd->bhncs', q, k) * decay, 0.0)

    def step(state, inp):
        qc, kc, uc, wc, ac, gcc = inp
        v_new = uc - jnp.einsum('bhcd,bhde->bhce', wc, state)
        o = (jnp.einsum('bhcd,bhde->bhce', qc * jnp.exp(gcc)[..., None], state)
             + jnp.einsum('bhcs,bhse->bhce', ac, v_new))
        g_last = gcc[..., -1:]
        state = (state * jnp.exp(g_last)[..., None]
                 + jnp.einsum('bhcd,bhce->bhde', kc * jnp.exp(g_last - gcc)[..., None], v_new))
        return state, o

    xs = tuple(jnp.moveaxis(t, 2, 0) for t in (q, k, u, w, a_intra, gc))
    state0 = jnp.zeros((bsz, h, dk, v.shape[-1]), jnp.float32)
    _, o = lax.scan(step, state0, xs)
    return jnp.transpose(o, (1, 0, 3, 2, 4)).reshape(bsz, s, h, -1)


def l2norm(t):
    return t * lax.rsqrt(jnp.sum(jnp.square(t), -1, keepdims=True) + RMS_EPS)


def delta_mixer(p, conv_w, a_log_f, a_log_b, dt_f, dt_b, norm_g):
    bsz, s, _ = p.shape
    f32 = jnp.float32
    qkv = jax.nn.silu(dwconv_centred(p[..., :3 * DN_W], conv_w)).astype(f32)
    q, k, v = (t.reshape(bsz, s, DN_HEADS, DN_DIM) for t in jnp.split(qkv, 3, axis=-1))
    q, k = l2norm(q), l2norm(k)
    z = p[..., 3 * DN_W:4 * DN_W].astype(f32)
    a_f, a_b, b_f, b_b = jnp.split(p[..., 4 * DN_W:].astype(f32), 4, axis=-1)
    g_f = -jnp.exp(a_log_f.astype(f32)) * jax.nn.softplus(a_f + dt_f.astype(f32))
    g_b = -jnp.exp(a_log_b.astype(f32)) * jax.nn.softplus(a_b + dt_b.astype(f32))
    o_f = gated_delta_chunked(q, k, v, g_f, jax.nn.sigmoid(b_f))
    rev = lambda t: jnp.flip(t, axis=1)
    o_b = rev(gated_delta_chunked(rev(q), rev(k), rev(v), rev(g_b), rev(jax.nn.sigmoid(b_b))))
    o = o_f + o_b
    o = o * lax.rsqrt(jnp.mean(jnp.square(o), -1, keepdims=True) + RMS_EPS) * norm_g.astype(f32)
    return (o.reshape(bsz, s, DN_W) * jax.nn.silu(z)).astype(p.dtype)


def encoder_layer(x, c, w_mod, b_mod, w_in, conv_a_w, attn_sink, dn_conv_w, dn_a_log_f, dn_a_log_b,
                  dn_dt_bias_f, dn_dt_bias_b, dn_norm_g, w_out, ln1_g, ln1_b, w1, b1, w2, b2, ln2_g, ln2_b):
    mod = jax.nn.silu(c) @ w_mod + b_mod
    sh1, sc1, g1, sh2, sc2, g2 = jnp.split(mod, 6, axis=-1)
    h = modulate(x, sh1, sc1)
    p = h @ w_in
    y_a = short_conv_mixer(p[..., :OFF_ATT], conv_a_w)
    q = p[..., OFF_ATT:OFF_ATT + ATT_Q]
    k = p[..., OFF_ATT + ATT_Q:OFF_ATT + ATT_Q + ATT_KV]
    v = p[..., OFF_ATT + ATT_Q + ATT_KV:OFF_DN]
    y_b = window_attention(q, k, v, attn_sink)
    y_c = delta_mixer(p[..., OFF_DN:], dn_conv_w, dn_a_log_f, dn_a_log_b, dn_dt_bias_f, dn_dt_bias_b, dn_norm_g)
    y = jnp.concatenate([y_a, y_b, y_c], axis=-1) @ w_out
    x = layer_norm(ALPHA * x + (1 + g1[:, None, :]) * y, ln1_g, ln1_b)
    h = modulate(x, sh2, sc2)
    f = jnp.square(jax.nn.relu(h @ w1 + b1)) @ w2 + b2
    return layer_norm(ALPHA * x + (1 + g2[:, None, :]) * f, ln2_g, ln2_b)


def trunk(x, c, ln_in_g, ln_in_b, w_mod, b_mod, w_in, conv_a_w, attn_sink, dn_conv_w, dn_a_log_f, dn_a_log_b,
          dn_dt_bias_f, dn_dt_bias_b, dn_norm_g, w_out, ln1_g, ln1_b, w1, b1, w2, b2, ln2_g, ln2_b):
    x = layer_norm(x, ln_in_g, ln_in_b)
    for l in range(DEPTH):
        x = encoder_layer(x, c, w_mod[l], b_mod[l], w_in[l], conv_a_w[l], attn_sink[l], dn_conv_w[l],
                          dn_a_log_f[l], dn_a_log_b[l], dn_dt_bias_f[l], dn_dt_bias_b[l], dn_norm_g[l],
                          w_out[l], ln1_g[l], ln1_b[l], w1[l], b1[l], w2[l], b2[l], ln2_g[l], ln2_b[l])
    return x


def setup_inputs(seed: int = 0) -> dict:
    key = jax.random.key(seed)
    ks = jax.random.split(key, 32)
    f32 = jnp.float32
    L = DEPTH
    nrm = lambda k, shape, scale: jax.random.normal(k, shape, f32) * scale
    return {
        'x_prompt': nrm(ks[0], (BATCH, SEQ, D_MODEL), 1.0),
        'x_sample': nrm(ks[1], (DEC_BATCH, DEC_SEQ, D_MODEL), 1.0),
        'c_prompt': nrm(ks[2], (BATCH, D_MODEL), 1.0),
        'c_sample': nrm(ks[3], (DEC_BATCH, D_MODEL), 1.0),
        'ln_in_g': 1.0 + nrm(ks[4], (D_MODEL,), 0.02),
        'ln_in_b': nrm(ks[5], (D_MODEL,), 0.02),
        'w_mod': nrm(ks[6], (L, D_MODEL, 6 * D_MODEL), 0.2 * D_MODEL ** -0.5),
        'b_mod': nrm(ks[7], (L, 6 * D_MODEL), 0.01),
        'w_in': nrm(ks[8], (L, D_MODEL, D_IN), D_MODEL ** -0.5),
        'conv_a_w': nrm(ks[9], (L, CONV_W, CONV_CH), CONV_W ** -0.5),
        'attn_sink': nrm(ks[10], (L, N_HEADS), 1.0),
        'dn_conv_w': nrm(ks[11], (L, DN_CONV_W, 3 * DN_W), DN_CONV_W ** -0.5),
        'dn_a_log_f': jnp.log(jax.random.uniform(ks[12], (L, DN_HEADS), f32, 1.0, 16.0)),
        'dn_a_log_b': jnp.log(jax.random.uniform(ks[13], (L, DN_HEADS), f32, 1.0, 16.0)),
        'dn_dt_bias_f': jnp.log(jnp.expm1(jax.random.uniform(ks[14], (L, DN_HEADS), f32, 1e-3, 1e-1))),
        'dn_dt_bias_b': jnp.log(jnp.expm1(jax.random.uniform(ks[15], (L, DN_HEADS), f32, 1e-3, 1e-1))),
        'dn_norm_g': 1.0 + nrm(ks[16], (L, DN_DIM), 0.02),
        'w_out': nrm(ks[17], (L, D_MIX, D_MODEL), BETA_INIT * D_MIX ** -0.5),
        'ln1_g': 1.0 + nrm(ks[18], (L, D_MODEL), 0.02),
        'ln1_b': nrm(ks[19], (L, D_MODEL), 0.02),
        'w1': nrm(ks[20], (L, D_MODEL, D_FF), D_MODEL ** -0.5),
        'b1': nrm(ks[21], (L, D_FF), 0.01),
        'w2': nrm(ks[22], (L, D_FF, D_MODEL), BETA_INIT * D_FF ** -0.5),
        'b2': nrm(ks[23], (L, D_MODEL), 0.01),
        'ln2_g': 1.0 + nrm(ks[24], (L, D_MODEL), 0.02),
        'ln2_b': nrm(ks[25], (L, D_MODEL), 0.02),
    }


def reference(x_prompt, x_sample, c_prompt, c_sample, ln_in_g, ln_in_b, w_mod, b_mod, w_in, conv_a_w, attn_sink,
              dn_conv_w, dn_a_log_f, dn_a_log_b, dn_dt_bias_f, dn_dt_bias_b, dn_norm_g, w_out, ln1_g, ln1_b,
              w1, b1, w2, b2, ln2_g, ln2_b):
    params = (ln_in_g, ln_in_b, w_mod, b_mod, w_in, conv_a_w, attn_sink, dn_conv_w, dn_a_log_f, dn_a_log_b,
              dn_dt_bias_f, dn_dt_bias_b, dn_norm_g, w_out, ln1_g, ln1_b, w1, b1, w2, b2, ln2_g, ln2_b)
    y_prompt = trunk(x_prompt, c_prompt, *params)
    y_sample = trunk(x_sample, c_sample, *params)
    return (y_prompt, y_sample)
```

```cpp
#include <hip/hip_runtime.h>
#include <hip/hip_cooperative_groups.h>
#include <cstdio>
#include <cstdint>
namespace cg = cooperative_groups;

#ifndef MK_MULTI
#define MK_MULTI 0
#endif

constexpr int D = 1024, DEPTH = 4;
constexpr int M_P = 4 * 4096, M_S = 8 * 8192, M = M_P + M_S;
constexpr int NBATCH = 12;
constexpr int D_IN = 2576, D_INP = 2816, D_FF = 4096;
constexpr int NCHUNK = M / 64;
constexpr float ALPHA = 1.681792830507429f;
__host__ __device__ __forceinline__ int batch_of_row(int m) { return m < M_P ? (m >> 12) : 4 + ((m - M_P) >> 13); }
__host__ __device__ __forceinline__ void batch_info(int b, int& row0, int& S) { if (b < 4) { row0 = b << 12; S = 4096; } else { row0 = M_P + ((b - 4) << 13); S = 8192; } }
namespace pg8 {
#define PG8_LAS __attribute__((address_space(3)))
typedef unsigned short bf16_t;
typedef short bf16x8 __attribute__((ext_vector_type(8)));
typedef float f32x4 __attribute__((ext_vector_type(4)));
typedef unsigned u32x4 __attribute__((ext_vector_type(4)));
constexpr int BM = 256, BK = 64, HALF = 128, HTB = HALF * BK * 2  , STAGE_BYTES = 8 * HTB, NXCD = 8, WGM = 8;

__host__ __device__ __forceinline__ int lds_byte(int r, int c) { const int st = (r >> 4) * 2 + (c >> 5), rr = r & 15, cc = c & 31, ob = rr * 64 + cc * 2; return st * 1024 + (ob ^ (((ob >> 9) & 1) << 5)); }
__host__ __device__ __forceinline__ void stage_rc(int b, int& R, int& C) { const int st = b / 1024, sb = b % 1024, swz = sb ^ (((sb >> 9) & 1) << 5); R = (st >> 1) * 16 + swz / 64; C = (st & 1) * 32 + (swz % 64) / 2; }
__host__ __device__ __forceinline__ int perm32(int rho) { const int n = rho >> 4, i = rho & 15; return 8 * (i >> 2) + 4 * n + (i & 3); }

struct Unit { int pm, pn; };
struct Gemm { const bf16_t* A; const bf16_t* Bt; int M, N, K; };

struct StaticOrder {
    int nM, nN, nwg, G, c;
    __host__ __device__ void init(int M, int N, int G_, int c_) { nM = M / BM; nN = N / BM; nwg = nM * nN; G = G_; c = c_; }
    __host__ __device__ bool next(int i, Unit& u) const {
        const long L = (long)i * G + c; if (L >= nwg) return false;
        int wgid = (int)L; { const int q = nwg / NXCD, r = nwg % NXCD, xcd = wgid % NXCD, off = wgid / NXCD; wgid = (xcd < r ? xcd * (q + 1) : r * (q + 1) + (xcd - r) * q) + off; }
        const int nig = WGM * nN, gid = wgid / nig, fm = gid * WGM, gsz = (nM - fm) < WGM ? (nM - fm) : WGM;
        u.pm = fm + ((wgid % nig) % gsz); u.pn = (wgid % nig) / gsz; return true;
    }
    __device__ __forceinline__ void a_ready(const Unit&) const {}
    __device__ __forceinline__ void done(const Unit&) const {}
};

typedef __bf16 bf16x2_t __attribute__((ext_vector_type(2)));
typedef float f32x2_t __attribute__((ext_vector_type(2)));
__device__ __forceinline__ unsigned cvt_pk_bf16(float lo, float hi) { const f32x2_t v = {lo, hi}; const bf16x2_t b = __builtin_convertvector(v, bf16x2_t); return __builtin_bit_cast(unsigned, b); }
typedef float f32x2 __attribute__((ext_vector_type(2)));
struct EpiP {
    static constexpr bool PERM = true, AFTER_DRAIN = false;
    bf16_t* O;
    __device__ __forceinline__ void operator()(const f32x4 (&acc)[2][2][4][2], const Unit& u, int wr, int wc, int fr, int fq) const {
        const int row0 = u.pm * BM + wr * 64 + fr; const int col0 = u.pn * BM + wc * 32 + 8 * fq;
#pragma unroll
        for (int ai = 0; ai < 2; ++ai)
#pragma unroll
            for (int m = 0; m < 4; ++m) { bf16_t* rowp = O + (size_t)(row0 + ai * HALF + m * 16) * 2576 + col0;
#pragma unroll
                for (int bj = 0; bj < 2; ++bj) { if (col0 + bj * HALF < 2576) { const f32x4 v0 = acc[ai][bj][m][0], v1 = acc[ai][bj][m][1];
                    u32x4 w; w.x = cvt_pk_bf16(v0[0], v0[1]); w.y = cvt_pk_bf16(v0[2], v0[3]); w.z = cvt_pk_bf16(v1[0], v1[1]); w.w = cvt_pk_bf16(v1[2], v1[3]);
                    *(u32x4*)(rowp + bj * HALF) = w; } } }
    }
};
struct EpiH {
    static constexpr bool PERM = true, AFTER_DRAIN = false;
    bf16_t* O; const float* bias;
    __device__ __forceinline__ void operator()(const f32x4 (&acc)[2][2][4][2], const Unit& u, int wr, int wc, int fr, int fq) const {
        const int row0 = u.pm * BM + wr * 64 + fr; const int col0 = u.pn * BM + wc * 32 + 8 * fq;
        f32x4 bv[2][2];
#pragma unroll
        for (int bj = 0; bj < 2; ++bj)
#pragma unroll
            for (int n = 0; n < 2; ++n) bv[bj][n] = *(const f32x4*)(bias + col0 + bj * HALF + 4 * n);
#pragma unroll
        for (int ai = 0; ai < 2; ++ai)
#pragma unroll
            for (int m = 0; m < 4; ++m) { bf16_t* rowp = O + (size_t)(row0 + ai * HALF + m * 16) * 4096 + col0;
#pragma unroll
                for (int bj = 0; bj < 2; ++bj) { f32x4 v0 = acc[ai][bj][m][0] + bv[bj][0], v1 = acc[ai][bj][m][1] + bv[bj][1];
                    v0 = __builtin_elementwise_max(v0, (f32x4){0.f, 0.f, 0.f, 0.f}); v1 = __builtin_elementwise_max(v1, (f32x4){0.f, 0.f, 0.f, 0.f}); v0 = v0 * v0; v1 = v1 * v1;
                    u32x4 w; w.x = cvt_pk_bf16(v0[0], v0[1]); w.y = cvt_pk_bf16(v0[2], v0[3]); w.z = cvt_pk_bf16(v1[0], v1[1]); w.w = cvt_pk_bf16(v1[2], v1[3]);
                    *(u32x4*)(rowp + bj * HALF) = w; } }
    }
};
struct EpiRes {
    static constexpr bool PERM = false, AFTER_DRAIN = false;
    float* X; const float* gate  ; const float* bias  ;
    __device__ __forceinline__ void operator()(const f32x4 (&acc)[2][2][4][2], const Unit& u, int wr, int wc, int fr, int fq) const {
        const int row0 = u.pm * BM + wr * 64 + fr; const int col0 = u.pn * BM + wc * 32 + 4 * fq;
        const float* gb = gate + (size_t)batch_of_row(u.pm * BM) * 6144;
        f32x4 gv[2][2], bv[2][2];
#pragma unroll
        for (int bj = 0; bj < 2; ++bj)
#pragma unroll
            for (int n = 0; n < 2; ++n) { gv[bj][n] = *(const f32x4*)(gb + col0 + bj * HALF + n * 16) + 1.0f;
                bv[bj][n] = bias ? *(const f32x4*)(bias + col0 + bj * HALF + n * 16) : (f32x4){0.f, 0.f, 0.f, 0.f}; }
#pragma unroll
        for (int ai = 0; ai < 2; ++ai)
#pragma unroll
            for (int m = 0; m < 4; ++m) { float* xp = X + (size_t)(row0 + ai * HALF + m * 16) * 1024 + col0;
#pragma unroll
                for (int bj = 0; bj < 2; ++bj)
#pragma unroll
                    for (int n = 0; n < 2; ++n) { const f32x4 xo = *(const f32x4*)(xp + bj * HALF + n * 16);
                        *(f32x4*)(xp + bj * HALF + n * 16) = xo * ALPHA + gv[bj][n] * (acc[ai][bj][m][n] + bv[bj][n]); }
                asm volatile("" ::: "memory"); }
    }
};
template <class Epi, class Sched, bool ALIGN_EPI = false, bool SP2 = false>
__device__ __forceinline__ void gemm_phase(PG8_LAS unsigned char* lds, const Gemm g, const Sched& S, const Epi& E, const int tid) {
    const int wid = __builtin_amdgcn_readfirstlane(tid >> 6), lane = tid & 63, wr = wid >> 2, wc = wid & 3, fr = lane & 15, fq = lane >> 4;
    const int K = g.K, nt = K / BK;
    unsigned voffA[2], voffB[2];
#pragma unroll
    for (int i = 0; i < 2; ++i) { int R, C; stage_rc(tid * 16 + i * 8192, R, C); const int Rb = Epi::PERM ? ((R & ~31) + perm32(R & 31)) : R;
        voffA[i] = (unsigned)(R * K + C) * 2u; voffB[i] = (unsigned)(Rb * K + C) * 2u; }
    const size_t kstep = (size_t)(BK * 2);
    const size_t hstep = (size_t)HALF * K * 2;
    const size_t tstep = 2 * hstep;
    const unsigned ldsw = (unsigned)wid * 1024u;
    const int aoff = lds_byte(wr * 64 + fr, fq * 8), boff = lds_byte(wc * 32 + fr, fq * 8);
#define PG8_SA(b, h) (((b) * 2 + (h)) * HTB)
#define PG8_SB(b, h) ((4 + (b) * 2 + (h)) * HTB)
#define PG8_STAGE(bufoff, gbase, voff) do { _Pragma("unroll") for (int _i = 0; _i < 2; ++_i) \
        __builtin_amdgcn_global_load_lds((const unsigned*)((const char*)(gbase) + (voff)[_i]), (PG8_LAS unsigned*)(lds + (bufoff) + ldsw + _i * 8192), 16, 0, 0); } while (0)
#define PG8_LDA(dst, b, h) do { _Pragma("unroll") for (int m = 0; m < 4; ++m) _Pragma("unroll") for (int k = 0; k < 2; ++k) dst[m][k] = *(const PG8_LAS bf16x8*)(lds + PG8_SA(b, h) + aoff + m * 2048 + k * 1024); } while (0)
#define PG8_LDB(dst, b, h) do { _Pragma("unroll") for (int n = 0; n < 2; ++n) _Pragma("unroll") for (int k = 0; k < 2; ++k) dst[n][k] = *(const PG8_LAS bf16x8*)(lds + PG8_SB(b, h) + boff + n * 2048 + k * 1024); } while (0)
#define PG8_MMA(ai, bj, At, Bt) do { __builtin_amdgcn_s_setprio(1); _Pragma("unroll") for (int m = 0; m < 4; ++m) _Pragma("unroll") for (int n = 0; n < 2; ++n) _Pragma("unroll") for (int k = 0; k < 2; ++k) \
        acc[ai][bj][m][n] = __builtin_amdgcn_mfma_f32_16x16x32_bf16(Bt[n][k], At[m][k], acc[ai][bj][m][n], 0, 0, 0); __builtin_amdgcn_s_setprio(0); } while (0)
#define PG8_WAIT_V(n) asm volatile("s_waitcnt vmcnt(" #n ")" ::: "memory")
#define PG8_WAIT_L(n) asm volatile("s_waitcnt lgkmcnt(" #n ")" ::: "memory")
#define PG8_BAR __builtin_amdgcn_s_barrier()
#define PG8_SCHED __builtin_amdgcn_sched_barrier(0)
    Unit cur, nxt; int ui = 0;
    if (!S.next(0, cur)) return;
    f32x4 acc[2][2][4][2];
#pragma unroll
    for (int a = 0; a < 2; ++a)
#pragma unroll
        for (int b = 0; b < 2; ++b)
#pragma unroll
            for (int m = 0; m < 4; ++m)
#pragma unroll
                for (int n = 0; n < 2; ++n) acc[a][b][m][n] = (f32x4){0.f, 0.f, 0.f, 0.f};
    bf16x8 At[4][2], B0[2][2], B1[2][2];
    const char* cA = (const char*)g.A + (size_t)cur.pm * tstep; const char* cB = (const char*)g.Bt + (size_t)cur.pn * tstep;
    S.a_ready(cur);
    if constexpr (SP2) {
        PG8_STAGE(PG8_SB(0, 0), cB, voffB); PG8_STAGE(PG8_SB(0, 1), cB + hstep, voffB); PG8_STAGE(PG8_SA(0, 0), cA, voffA); PG8_STAGE(PG8_SA(0, 1), cA + hstep, voffA);
        if (wr == 1) PG8_BAR;
        PG8_WAIT_V(2); PG8_BAR;
        PG8_STAGE(PG8_SB(1, 0), cB + kstep, voffB); PG8_STAGE(PG8_SA(1, 0), cA + kstep, voffA); PG8_STAGE(PG8_SB(1, 1), cB + hstep + kstep, voffB);
        PG8_WAIT_V(6); PG8_BAR;
    } else {
        PG8_STAGE(PG8_SB(0, 0), cB, voffB); PG8_STAGE(PG8_SA(0, 0), cA, voffA); PG8_STAGE(PG8_SB(0, 1), cB + hstep, voffB); PG8_STAGE(PG8_SA(0, 1), cA + hstep, voffA);
        if (wr == 1) PG8_BAR;
        PG8_WAIT_V(4); PG8_BAR;
        PG8_STAGE(PG8_SB(1, 0), cB + kstep, voffB); PG8_STAGE(PG8_SA(1, 0), cA + kstep, voffA); PG8_STAGE(PG8_SB(1, 1), cB + hstep + kstep, voffB);
        PG8_WAIT_V(6); PG8_BAR;
    }
    for (;;) {
        const bool has_next = S.next(ui + 1, nxt);
        const char* nA = has_next ? (const char*)g.A + (size_t)nxt.pm * tstep : cA; const char* nB = has_next ? (const char*)g.Bt + (size_t)nxt.pn * tstep : cB;
        for (int t = 0; t < nt; t += 2) {
            const bool last = (t == nt - 2);
            const char* a1 = cA + (size_t)(t + 1) * kstep;
            const char* a2 = last ? nA : cA + (size_t)(t + 2) * kstep; const char* b2 = last ? nB : cB + (size_t)(t + 2) * kstep;
            const char* a3 = a2 + kstep; const char* b3 = b2 + kstep;
            if (last && has_next) S.a_ready(nxt);
            if constexpr (SP2) {
            PG8_LDB(B0, 0, 0); PG8_LDB(B1, 0, 1); PG8_SCHED; PG8_LDA(At, 0, 0); PG8_STAGE(PG8_SA(1, 1), a1 + hstep, voffA);
            PG8_WAIT_V(8); PG8_WAIT_L(0); PG8_BAR; PG8_MMA(0, 0, At, B0); PG8_MMA(0, 1, At, B1); PG8_BAR; PG8_SCHED;
            PG8_LDA(At, 0, 1); PG8_STAGE(PG8_SB(0, 0), b2, voffB); PG8_STAGE(PG8_SB(0, 1), b2 + hstep, voffB); PG8_STAGE(PG8_SA(0, 0), a2, voffA);
            PG8_WAIT_V(8); PG8_WAIT_L(0); PG8_BAR; PG8_MMA(1, 0, At, B0); PG8_MMA(1, 1, At, B1); PG8_BAR; PG8_SCHED;
            PG8_LDB(B0, 1, 0); PG8_LDB(B1, 1, 1); PG8_SCHED; PG8_LDA(At, 1, 0); PG8_STAGE(PG8_SA(0, 1), a2 + hstep, voffA);
            PG8_WAIT_V(8); PG8_WAIT_L(0); PG8_BAR; PG8_MMA(0, 0, At, B0); PG8_MMA(0, 1, At, B1); PG8_BAR; PG8_SCHED;
            PG8_LDA(At, 1, 1); PG8_STAGE(PG8_SB(1, 0), b3, voffB); PG8_STAGE(PG8_SB(1, 1), b3 + hstep, voffB); PG8_STAGE(PG8_SA(1, 0), a3, voffA);
            PG8_WAIT_V(8); PG8_WAIT_L(0); PG8_BAR; PG8_MMA(1, 0, At, B0); PG8_MMA(1, 1, At, B1); PG8_BAR; PG8_SCHED;
            } else {
            PG8_LDB(B0, 0, 0); PG8_SCHED; PG8_LDA(At, 0, 0); PG8_STAGE(PG8_SA(1, 1), a1 + hstep, voffA);
            PG8_WAIT_L(8); PG8_BAR; PG8_WAIT_L(0); PG8_MMA(0, 0, At, B0); PG8_BAR; PG8_SCHED;
            PG8_LDB(B1, 0, 1); PG8_STAGE(PG8_SB(0, 0), b2, voffB);
            PG8_BAR; PG8_WAIT_L(0); PG8_MMA(0, 1, At, B1); PG8_BAR;
            PG8_LDA(At, 0, 1); PG8_STAGE(PG8_SA(0, 0), a2, voffA);
            PG8_BAR; PG8_WAIT_L(0); PG8_MMA(1, 0, At, B0); PG8_BAR; PG8_SCHED;
            PG8_STAGE(PG8_SB(0, 1), b2 + hstep, voffB);
            PG8_WAIT_V(6); PG8_BAR; PG8_MMA(1, 1, At, B1); PG8_BAR;
            PG8_LDB(B0, 1, 0); PG8_SCHED; PG8_LDA(At, 1, 0); PG8_STAGE(PG8_SA(0, 1), a2 + hstep, voffA);
            PG8_WAIT_L(8); PG8_BAR; PG8_WAIT_L(0); PG8_MMA(0, 0, At, B0); PG8_BAR; PG8_SCHED;
            PG8_LDB(B1, 1, 1); PG8_STAGE(PG8_SB(1, 0), b3, voffB);
            PG8_BAR; PG8_WAIT_L(0); PG8_MMA(0, 1, At, B1); PG8_BAR;
            PG8_LDA(At, 1, 1); PG8_STAGE(PG8_SA(1, 0), a3, voffA);
            PG8_BAR; PG8_WAIT_L(0); PG8_MMA(1, 0, At, B0); PG8_BAR; PG8_SCHED;
            PG8_STAGE(PG8_SB(1, 1), b3 + hstep, voffB);
            PG8_WAIT_V(6); PG8_BAR; PG8_MMA(1, 1, At, B1); PG8_BAR;
            }
        }
        if constexpr (ALIGN_EPI) { if (wr == 0) PG8_BAR; }
        if constexpr (!Epi::AFTER_DRAIN) { E(acc, cur, wr, wc, fr, fq); S.done(cur); }
        if (!has_next) break;
#pragma unroll
        for (int a = 0; a < 2; ++a)
#pragma unroll
            for (int b = 0; b < 2; ++b)
#pragma unroll
                for (int m = 0; m < 4; ++m)
#pragma unroll
                    for (int n = 0; n < 2; ++n) acc[a][b][m][n] = (f32x4){0.f, 0.f, 0.f, 0.f};
        cur = nxt; cA = nA; cB = nB; ++ui;
        if constexpr (ALIGN_EPI) { if (wr == 1) PG8_BAR; }
    }
    PG8_WAIT_V(0);
    if constexpr (!ALIGN_EPI) { if (wr == 0) PG8_BAR; }
    PG8_BAR;
    if constexpr (Epi::AFTER_DRAIN) { E.fused(acc, cur, wr, wc, fr, fq, lds, wid, lane); S.done(cur); }
#undef PG8_SA
#undef PG8_SB
#undef PG8_STAGE
#undef PG8_LDA
#undef PG8_LDB
#undef PG8_MMA
#undef PG8_WAIT_V
#undef PG8_WAIT_L
#undef PG8_BAR
#undef PG8_SCHED
}
}

#define GAS __attribute__((address_space(1)))
#define LAS __attribute__((address_space(3)))
typedef unsigned short bf16;
typedef unsigned v4u __attribute__((ext_vector_type(4)));
typedef unsigned v2u __attribute__((ext_vector_type(2)));
typedef float f32x4 __attribute__((ext_vector_type(4)));
typedef short bf16x8 __attribute__((ext_vector_type(8)));
constexpr int NTHREADS = 512;
constexpr int LDS_BYTES = 147456;
constexpr int NSCAN = 48;

constexpr size_t MiB = 1u << 20;
constexpr size_t WS_MOD = 0;
constexpr size_t WS_EGL = WS_MOD + (size_t)DEPTH * NBATCH * 6144 * 4;
constexpr size_t WS_WIN = 2 * MiB, WS_WOUT = WS_WIN + (size_t)D_INP * D * 2, WS_W1 = WS_WOUT + (size_t)D * D * 2, WS_W2 = WS_W1 + (size_t)D_FF * D * 2;
constexpr size_t WS_P = 26 * MiB;
constexpr size_t WS_H = 26 * MiB;
constexpr size_t WS_NEGW = 429 * MiB, WS_UT = 509 * MiB, WS_QH = 589 * MiB, WS_EG = 629 * MiB;
constexpr size_t WS_XN = 666 * MiB;
constexpr size_t WS_AM = 826 * MiB, WS_KDT = 906 * MiB, WS_END = 986 * MiB;
static_assert(WS_W2 + (size_t)D * D_FF * 2 <= WS_P && WS_P + (size_t)M * D_IN * 2 <= WS_NEGW && WS_EG + (size_t)NCHUNK * 8 * 64 * 4 <= WS_XN && WS_H + (size_t)M * D_FF * 2 <= WS_XN && WS_EGL + NCHUNK * 8 * 4 <= WS_WIN, "ws map");

__device__ __forceinline__ float bflo(unsigned u) { return __builtin_bit_cast(float, u << 16); }
__device__ __forceinline__ float bfhi(unsigned u) { return __builtin_bit_cast(float, u & 0xffff0000u); }
__device__ __forceinline__ float bf1(bf16 u) { return __builtin_bit_cast(float, (unsigned)u << 16); }
__device__ __forceinline__ unsigned pk2(float lo, float hi) { return pg8::cvt_pk_bf16(lo, hi); }
__device__ __forceinline__ bf16 f2bf(float v) { return __builtin_bit_cast(unsigned short, (__bf16)v); }
__device__ __forceinline__ float wave_sum(float v) {
#pragma unroll
    for (int o = 1; o < 64; o <<= 1) v += __shfl_xor(v, o);
    return v;
}
__device__ __forceinline__ int dmap(int p) { return 16 * ((p >> 2) & 1) + 4 * (p >> 3) + (p & 3); }
__device__ __forceinline__ int ppos(int d) { return 8 * ((d >> 2) & 3) + 4 * (d >> 4) + (d & 3); }
#define MFMA_BF16(a, b, c) __builtin_amdgcn_mfma_f32_16x16x32_bf16((a), (b), (c), 0, 0, 0)

struct Args { const float* in[26]; float* out; unsigned char* ws; int ph_lo, ph_hi; };

__device__ __forceinline__ void transpose_item(const float* W, int K, int N, bf16* WT, LAS float* scr, int item, int nblk, int lane) {
    const int kb = item / nblk, nb = item % nblk, k0 = 64 * kb, n0 = 32 * nb;
    const int nn = n0 + (lane & 31);
#pragma unroll 8
    for (int i = 0; i < 32; ++i) { const int kk = 2 * i + (lane >> 5); scr[kk * 33 + (lane & 31)] = nn < N ? W[(size_t)(k0 + kk) * N + nn] : 0.f; }
    asm volatile("s_waitcnt lgkmcnt(0)" ::: "memory");
    const int c = lane & 7;
#pragma unroll
    for (int j = 0; j < 4; ++j) { const int n = (lane >> 3) + 8 * j; const LAS float* s = scr + (8 * c) * 33 + n;
        v4u o; o.x = pk2(s[0 * 33], s[1 * 33]); o.y = pk2(s[2 * 33], s[3 * 33]); o.z = pk2(s[4 * 33], s[5 * 33]); o.w = pk2(s[6 * 33], s[7 * 33]);
        *(v4u*)(WT + (size_t)(n0 + n) * K + k0 + 8 * c) = o; }
    asm volatile("s_waitcnt lgkmcnt(0)" ::: "memory");
}
__device__ __forceinline__ void convert_layer(const Args& a, unsigned char* ws, int l, LAS unsigned char* lds, int gw, int NGW, int wave, int lane) {
    LAS float* scr = (LAS float*)(lds + wave * 16384);
    const float* Win = a.in[8] + (size_t)l * D * D_IN; const float* Wout = a.in[17] + (size_t)l * D * D;
    const float* W1 = a.in[20] + (size_t)l * D * D_FF; const float* W2 = a.in[22] + (size_t)l * D_FF * D;
    bf16* WinT = (bf16*)(ws + WS_WIN); bf16* WoutT = (bf16*)(ws + WS_WOUT); bf16* W1T = (bf16*)(ws + WS_W1); bf16* W2T = (bf16*)(ws + WS_W2);
    constexpr int I_IN = 16 * 88, I_OUT = 16 * 32, I_1 = 16 * 128, I_2 = 64 * 32;
    for (int it = gw; it < I_IN + I_OUT + I_1 + I_2; it += NGW) {
        int r = it;
        if (r < I_IN) { transpose_item(Win, D, D_IN, WinT, scr, r, 88, lane); continue; } r -= I_IN;
        if (r < I_OUT) { transpose_item(Wout, D, D, WoutT, scr, r, 32, lane); continue; } r -= I_OUT;
        if (r < I_1) { transpose_item(W1, D, D_FF, W1T, scr, r, 128, lane); continue; } r -= I_1;
        transpose_item(W2, D_FF, D, W2T, scr, r, 32, lane);
    }
}
__device__ __forceinline__ void mod_phase(const Args& a, unsigned char* ws, LAS unsigned char* lds, int tid, int wave, int lane, int bid, int G) {
    LAS float* sc = (LAS float*)lds;
    LAS float* red = (LAS float*)(lds + 49152);
    float* modbuf = (float*)(ws + WS_MOD);
    for (int i = tid; i < NBATCH * 1024; i += NTHREADS) { const int b = i >> 10, k = i & 1023; const float c = b < 4 ? a.in[2][b * 1024 + k] : a.in[3][(b - 4) * 1024 + k]; sc[i] = c / (1.f + __expf(-c)); }
    __syncthreads();
    for (int unit = bid; unit < DEPTH * 96; unit += G) {
        const int l = unit / 96, jb = unit % 96;
        const float* W = a.in[6] + (size_t)l * D * 6144 + jb * 64 + lane;
        float acc[NBATCH];
#pragma unroll
        for (int b = 0; b < NBATCH; ++b) acc[b] = 0.f;
#pragma unroll 4
        for (int k = wave * 128; k < wave * 128 + 128; ++k) { const float w = W[(size_t)k * 6144];
#pragma unroll
            for (int b = 0; b < NBATCH; ++b) acc[b] += sc[b * 1024 + k] * w; }
#pragma unroll
        for (int b = 0; b < NBATCH; ++b) red[(wave * NBATCH + b) * 64 + lane] = acc[b];
        __syncthreads();
        for (int i = tid; i < NBATCH * 64; i += NTHREADS) { const int b = i >> 6, ln = i & 63; float s = 0.f;
#pragma unroll
            for (int w = 0; w < 8; ++w) s += red[(w * NBATCH + b) * 64 + ln];
            modbuf[(size_t)(l * NBATCH + b) * 6144 + jb * 64 + ln] = s + a.in[7][l * 6144 + jb * 64 + ln]; }
        __syncthreads();
    }
}

__device__ __forceinline__ void ln_rows(const float* xp, const float* xs, bool in_mode, float* X, const float* gam, const float* bet, const float* modl, int sh_off, bf16* XN, int gw, int NGW, int lane) {
    for (int m = gw; m < M; m += NGW) {
        const float* src = in_mode ? (m < M_P ? xp + (size_t)m * D : xs + (size_t)(m - M_P) * D) : X + (size_t)m * D;
        f32x4 v[4]; float s = 0.f;
#pragma unroll
        for (int j = 0; j < 4; ++j) { v[j] = ((const f32x4*)src)[lane + 64 * j]; s += (v[j].x + v[j].y) + (v[j].z + v[j].w); }
        const float mean = wave_sum(s) * (1.f / D); float s2 = 0.f;
#pragma unroll
        for (int j = 0; j < 4; ++j) { v[j] = v[j] - mean; s2 += (v[j].x * v[j].x + v[j].y * v[j].y) + (v[j].z * v[j].z + v[j].w * v[j].w); }
        const float rstd = 1.f / sqrtf(wave_sum(s2) * (1.f / D) + 1e-5f);
        const float* mrow = modl ? modl + (size_t)batch_of_row(m) * 6144 + sh_off : nullptr;
#pragma unroll
        for (int j = 0; j < 4; ++j) { const int c4 = lane + 64 * j;
            const f32x4 y = v[j] * rstd * ((const f32x4*)gam)[c4] + ((const f32x4*)bet)[c4];
            ((f32x4*)(X + (size_t)m * D))[c4] = y;
            if (XN) { const f32x4 h = y * (((const f32x4*)(mrow + 1024))[c4] + 1.0f) + ((const f32x4*)mrow)[c4];
                v2u w; w.x = pk2(h.x, h.y); w.y = pk2(h.z, h.w); ((v2u*)(XN + (size_t)m * D))[c4] = w; } }
    }
}

__device__ __forceinline__ void conv_items(const bf16* P, bf16* mix, const float* cw  , int first, int stride) {
#pragma unroll 1
    for (int it = first; it < M * 32; it += stride) {
        const int m = it >> 5, c0 = (it & 31) * 8;
        const int b = batch_of_row(m); int row0, S; batch_info(b, row0, S); const int t = m - row0;
        const bf16* pr = P + (size_t)m * D_IN + c0;
        const v4u zz = {0u, 0u, 0u, 0u};
        const v4u bg = *(const v4u*)pr;
        const v4u c1 = *(const v4u*)(pr + 256), u1 = *(const v4u*)(pr + 512);
        const v4u cm = t > 0 ? *(const v4u*)(pr - D_IN + 256) : zz, um = t > 0 ? *(const v4u*)(pr - D_IN + 512) : zz;
        const v4u cp = t < S - 1 ? *(const v4u*)(pr + D_IN + 256) : zz, up = t < S - 1 ? *(const v4u*)(pr + D_IN + 512) : zz;
        v4u o;
#pragma unroll
        for (int e = 0; e < 4; ++e) {
            const float w0l = cw[c0 + 2 * e], w0h = cw[c0 + 2 * e + 1], w1l = cw[256 + c0 + 2 * e], w1h = cw[256 + c0 + 2 * e + 1], w2l = cw[512 + c0 + 2 * e], w2h = cw[512 + c0 + 2 * e + 1];
            const float yl = bflo(bg[e]) * (w0l * bflo(cm[e]) * bflo(um[e]) + w1l * bflo(c1[e]) * bflo(u1[e]) + w2l * bflo(cp[e]) * bflo(up[e]));
            const float yh = bfhi(bg[e]) * (w0h * bfhi(cm[e]) * bfhi(um[e]) + w1h * bfhi(c1[e]) * bfhi(u1[e]) + w2h * bfhi(cp[e]) * bfhi(up[e]));
            o[e] = pk2(yl, yh);
        }
        *(v4u*)(mix + (size_t)m * D + c0) = o;
    }
}

__device__ __forceinline__ void attn_unit(const bf16* P, bf16* mix, const float* sinkl, int u, LAS unsigned char* lds, int tid, int wave, int lane) {
    int b, r;
    if (u < 256) { b = u >> 6; r = u & 63; } else { b = 4 + ((u - 256) >> 7); r = (u - 256) & 127; }
    const int qb = r >> 1, hk = r & 1;
    int row0, S; batch_info(b, row0, S);
    const int q0 = qb * 128;
    LAS bf16* Ks = (LAS bf16*)lds;
    LAS bf16* Vt = (LAS bf16*)(lds + 57600);
#pragma unroll 1
    for (int idx = tid; idx < 3200; idx += NTHREADS) {
        const int kk = idx >> 3, dg = idx & 7; const int t = q0 - 128 + kk;
        v4u kv = {0u, 0u, 0u, 0u}, vv = {0u, 0u, 0u, 0u};
        if (t >= 0 && t < S) { const bf16* pr = P + (size_t)(row0 + t) * D_IN + 1280 + hk * 64 + dg * 8; kv = *(const v4u*)pr; vv = *(const v4u*)(pr + 128); }
        *(LAS v4u*)(Ks + kk * 72 + dg * 8) = kv;
#pragma unroll
        for (int e = 0; e < 4; ++e) { Vt[(dg * 8 + 2 * e) * 408 + kk] = (bf16)(vv[e] & 0xffffu); Vt[(dg * 8 + 2 * e + 1) * 408 + kk] = (bf16)(vv[e] >> 16); }
    }
    __syncthreads();
    const int fr = lane & 15, fq = lane >> 4;
    const int qa = q0 + 16 * wave;
    const size_t qrow = (size_t)(row0 + qa + fr);
#pragma unroll 1
    for (int g = 0; g < 4; ++g) {
        const int h = hk * 4 + g;
        int frl = fr; asm volatile("" : "+v"(frl));
        const float slope = exp2f(-(float)(h + 1)); const float sink = sinkl[h];
        bf16x8 qf[2];
#pragma unroll
        for (int ks = 0; ks < 2; ++ks) qf[ks] = *(const bf16x8*)(P + qrow * D_IN + 768 + h * 64 + 32 * ks + 8 * fq);
        float sc[18][4]; float mx = -INFINITY;
#pragma unroll
        for (int kt = 0; kt < 18; ++kt) {
            f32x4 acc = {0.f, 0.f, 0.f, 0.f};
#pragma unroll
            for (int ks = 0; ks < 2; ++ks) { const bf16x8 kf = *(const LAS bf16x8*)(Ks + (16 * wave + 16 * kt + fr) * 72 + 32 * ks + 8 * fq); acc = MFMA_BF16(kf, qf[ks], acc); }
#pragma unroll
            for (int j = 0; j < 4; ++j) { const int rel = 16 * kt + 4 * fq + j - 128 - frl; const int kpos = qa + frl + rel;
                const bool ok = rel >= -128 && rel <= 128 && kpos >= 0 && kpos < S;
                const float s = ok ? acc[j] * 0.125f - slope * fabsf((float)rel) : -INFINITY; sc[kt][j] = s; mx = fmaxf(mx, s); }
            if (kt & 1) __builtin_amdgcn_sched_barrier(0);
        }
        mx = fmaxf(mx, __shfl_xor(mx, 16)); mx = fmaxf(mx, __shfl_xor(mx, 32));
        const float mm = fmaxf(mx, sink);
        float sum = 0.f;
#pragma unroll
        for (int kt = 0; kt < 18; ++kt)
#pragma unroll
            for (int j = 0; j < 4; ++j) { const float e = __expf(sc[kt][j] - mm); sc[kt][j] = e; sum += e; }
        sum += __shfl_xor(sum, 16); sum += __shfl_xor(sum, 32);
        const float inv = 1.f / (sum + __expf(sink - mm));
        bf16x8 pb[9];
#pragma unroll
        for (int c = 0; c < 9; ++c) { v4u w; w.x = pk2(sc[2 * c][0] * inv, sc[2 * c][1] * inv); w.y = pk2(sc[2 * c][2] * inv, sc[2 * c][3] * inv);
            w.z = pk2(sc[2 * c + 1][0] * inv, sc[2 * c + 1][1] * inv); w.w = pk2(sc[2 * c + 1][2] * inv, sc[2 * c + 1][3] * inv); pb[c] = __builtin_bit_cast(bf16x8, w); }
#pragma unroll 1
        for (int dt = 0; dt < 4; ++dt) {
            f32x4 acc = {0.f, 0.f, 0.f, 0.f};
#pragma unroll
            for (int c = 0; c < 9; ++c) { const LAS bf16* vp = Vt + (16 * dt + fr) * 408 + 16 * wave + 32 * c + 4 * fq;
                const v2u lo = *(const LAS v2u*)vp, hi = *(const LAS v2u*)(vp + 16);
                v4u w; w.x = lo.x; w.y = lo.y; w.z = hi.x; w.w = hi.y; acc = MFMA_BF16(__builtin_bit_cast(bf16x8, w), pb[c], acc); }
            v2u w; w.x = pk2(acc[0], acc[1]); w.y = pk2(acc[2], acc[3]);
            *(v2u*)(mix + qrow * D + 256 + h * 64 + 16 * dt + 4 * fq) = w;
        }
    }
    __syncthreads();
}

__device__ __forceinline__ void dn_prep(const Args& a, unsigned char* ws, int l, LAS unsigned char* lds, int tid, int wave, int lane, int bid, int G) {
    const bf16* P = (const bf16*)(ws + WS_P);
    bf16* negw = (bf16*)(ws + WS_NEGW); bf16* uT = (bf16*)(ws + WS_UT); bf16* qhat = (bf16*)(ws + WS_QH); float* eg = (float*)(ws + WS_EG);
    float* egl = (float*)(ws + WS_EGL); bf16* Am = (bf16*)(ws + WS_AM); bf16* kdT = (bf16*)(ws + WS_KDT);
    LAS float* qh = (LAS float*)lds;
    LAS float* kh = qh + 64 * 65;
    LAS float* vv = kh + 64 * 65;
    LAS float* Ls = (LAS float*)(lds + 49920);
    LAS float* gcs = (LAS float*)(lds + 82688);
    LAS float* bts = gcs + 128;
    LAS float* bws = bts + 128;
    const int fr = lane & 15, fq = lane >> 4;
    for (int unit = bid; unit < NCHUNK * 4; unit += G) {
        const int cgi = unit >> 2, h = unit & 3;
        const int rowc = cgi * 64;
        const int b = batch_of_row(rowc); int row0, S; batch_info(b, row0, S);
        const int t0 = rowc - row0;
        const size_t cid0 = ((size_t)cgi * 4 + h) * 2;
        { const int i = tid >> 3, dg = tid & 7; const int t = t0 + i;
          const bf16* pr = P + (size_t)(rowc + i) * D_IN + 1536 + h * 64 + dg * 8;
          const float* cw = a.in[11] + (size_t)l * 3 * 768 + h * 64 + dg * 8;
          const v4u zz = {0u, 0u, 0u, 0u};
#pragma unroll
          for (int wq = 0; wq < 3; ++wq) {
              const v4u r0 = t > 0 ? *(const v4u*)(pr - D_IN + wq * 256) : zz, r1 = *(const v4u*)(pr + wq * 256), r2 = t < S - 1 ? *(const v4u*)(pr + D_IN + wq * 256) : zz;
              LAS float* dst = (wq == 0 ? qh : (wq == 1 ? kh : vv)) + i * 65 + dg * 8;
#pragma unroll
              for (int e = 0; e < 4; ++e) {
                  const float* c0 = cw + wq * 256 + 2 * e;
                  float yl = c0[0] * bflo(r0[e]) + c0[768] * bflo(r1[e]) + c0[1536] * bflo(r2[e]);
                  float yh = c0[1] * bfhi(r0[e]) + c0[769] * bfhi(r1[e]) + c0[1537] * bfhi(r2[e]);
                  dst[2 * e] = yl / (1.f + __expf(-yl)); dst[2 * e + 1] = yh / (1.f + __expf(-yh));
              }
          } }
        __syncthreads();
        { const int pair = tid >> 2, sub = tid & 3, which = pair >> 6, i = pair & 63;
          LAS float* rowp = (which ? kh : qh) + i * 65 + sub * 16;
          float vals[16]; float s = 0.f;
#pragma unroll
          for (int e = 0; e < 16; ++e) { vals[e] = rowp[e]; s += vals[e] * vals[e]; }
          s += __shfl_xor(s, 1); s += __shfl_xor(s, 2);
          const float rs = (1.f / sqrtf(s + 1e-6f)) * (which ? 1.f : 0.125f);
#pragma unroll
          for (int e = 0; e < 16; ++e) rowp[e] = vals[e] * rs; }
        if (wave < 2) { const int dir = wave, ip = lane, io = dir ? 63 - ip : ip;
          const bf16* pr = P + (size_t)(rowc + io) * D_IN + 2560 + h;
          const float av = bf1(pr[dir * 4]), bv = bf1(pr[8 + dir * 4]);
          const float alog = a.in[12 + dir][l * 4 + h], dtb = a.in[14 + dir][l * 4 + h];
          const float xx = av + dtb; const float sp = xx > 20.f ? xx : log1pf(expf(xx));
          const float gg = -expf(alog) * sp; const float beta = 1.f / (1.f + expf(-bv));
          float c = gg;
#pragma unroll
          for (int off = 1; off < 64; off <<= 1) { const float tt = __shfl_up(c, off); if (lane >= off) c += tt; }
          gcs[dir * 64 + ip] = c; bts[dir * 64 + ip] = beta; bws[dir * 64 + ip] = beta * expf(c); }
        __syncthreads();
        { const int which = wave >> 2, ti = wave & 3;
          const LAS float* Arow = (which ? qh : kh) + (16 * ti + fr) * 65;
          f32x4 acc[4];
#pragma unroll
          for (int tj = 0; tj < 4; ++tj) acc[tj] = (f32x4){0.f, 0.f, 0.f, 0.f};
#pragma unroll
          for (int kk = 0; kk < 16; ++kk) { const float av = Arow[4 * kk + fq];
#pragma unroll
              for (int tj = 0; tj < 4; ++tj) { const float bv = kh[(16 * tj + fr) * 65 + 4 * kk + fq]; acc[tj] = __builtin_amdgcn_mfma_f32_16x16x4f32(av, bv, acc[tj], 0, 0, 0); } }
#pragma unroll
          for (int tj = 0; tj < 4; ++tj)
#pragma unroll
              for (int j = 0; j < 4; ++j) { const int i = 16 * ti + 4 * fq + j, jc = 16 * tj + fr, i1 = 63 - i, j1 = 63 - jc; const float val = acc[tj][j];
                  if (which == 0) {
                      const float d0 = jc < i ? gcs[i] - gcs[jc] : 0.f, d1 = j1 < i1 ? gcs[64 + i1] - gcs[64 + j1] : 0.f;
                      Ls[i * 64 + jc] = jc < i ? bts[i] * val * __expf(d0) : 0.f;
                      Ls[4096 + i1 * 64 + j1] = j1 < i1 ? bts[64 + i1] * val * __expf(d1) : 0.f;
                  } else {
                      const float d0 = jc <= i ? gcs[i] - gcs[jc] : 0.f, d1 = j1 <= i1 ? gcs[64 + i1] - gcs[64 + j1] : 0.f;
                      Am[cid0 * 4096 + i * 64 + (jc & 32) + ppos(jc & 31)] = f2bf(jc <= i ? val * __expf(d0) : 0.f);
                      Am[(cid0 + 1) * 4096 + i1 * 64 + (j1 & 32) + ppos(j1 & 31)] = f2bf(j1 <= i1 ? val * __expf(d1) : 0.f);
                  } } }
        __syncthreads();
        if (wave < 4) {
            const int dir = wave >> 1, col = tid & 127; const bool isW = (wave & 1) != 0;
            int st = dir ? -65 : 65; asm volatile("" : "+v"(st));
            const LAS float* sp = (isW ? kh + (col - 64) : vv + col) + (dir ? 63 * 65 : 0);
            const LAS float* scl = (isW ? bws : bts) + dir * 64;
            const LAS float* Lr = Ls + dir * 4096;
            const size_t cid = cid0 + dir;
            float x[64];
#pragma unroll
            for (int i = 0; i < 64; ++i) x[i] = 0.f;
#pragma unroll
            for (int i = 0; i < 64; ++i) {
                float acc = scl[i] * *sp; sp += st;
#pragma unroll
                for (int j4 = 0; j4 < (i + 3) / 4; ++j4) { const f32x4 l4 = *(const LAS f32x4*)(Lr + i * 64 + 4 * j4);
                    acc -= l4.x * x[4 * j4]; acc -= l4.y * x[4 * j4 + 1]; acc -= l4.z * x[4 * j4 + 2]; acc -= l4.w * x[4 * j4 + 3]; }
                x[i] = acc;
            }
            if (!isW) {
                bf16* dst = uT + cid * 4096 + col * 64;
#pragma unroll
                for (int q = 0; q < 8; ++q) { v4u w; w.x = pk2(x[8 * q], x[8 * q + 1]); w.y = pk2(x[8 * q + 2], x[8 * q + 3]); w.z = pk2(x[8 * q + 4], x[8 * q + 5]); w.w = pk2(x[8 * q + 6], x[8 * q + 7]); *(v4u*)(dst + 8 * q) = w; }
            } else {
                const int dk = col - 64; bf16* dst = negw + cid * 4096 + (dk & 32) + ppos(dk & 31);
#pragma unroll
                for (int i = 0; i < 64; ++i) dst[i * 64] = f2bf(-x[i]);
            }
        } else {
            const int t2 = tid - 256;
            { const int i = t2 >> 2, part = t2 & 3, g32 = (part >> 1) * 32, pb = (part & 1) * 16;
              const LAS float* qr = qh + i * 65 + g32;
              v4u w0, w1;
#pragma unroll
              for (int e = 0; e < 4; ++e) { w0[e] = pk2(qr[dmap(pb + 2 * e)], qr[dmap(pb + 2 * e + 1)]); w1[e] = pk2(qr[dmap(pb + 8 + 2 * e)], qr[dmap(pb + 8 + 2 * e + 1)]); }
              bf16* dst = qhat + (size_t)(rowc + i) * 256 + h * 64 + 16 * part; *(v4u*)dst = w0; *(v4u*)(dst + 8) = w1; }
            const int dir = (wave - 4) >> 1; const size_t cid = cid0 + dir;
            if (((wave - 4) & 1) == 0) {
                const int dk = lane; const float gl = gcs[dir * 64 + 63];
                int st = dir ? -65 : 65; asm volatile("" : "+v"(st));
                const LAS float* kb = kh + dk + (dir ? 63 * 65 : 0);
                bf16* dst = kdT + cid * 4096 + dk * 64;
#pragma unroll
                for (int q = 0; q < 8; ++q) { float vals[8];
#pragma unroll
                    for (int e = 0; e < 8; ++e) { const int pos = 8 * q + e; const int ip = (pos & 32) + dmap(pos & 31); vals[e] = kb[ip * st] * __expf(gl - gcs[dir * 64 + ip]); }
                    v4u w; w.x = pk2(vals[0], vals[1]); w.y = pk2(vals[2], vals[3]); w.z = pk2(vals[4], vals[5]); w.w = pk2(vals[6], vals[7]); *(v4u*)(dst + 8 * q) = w; }
            } else {
                const float e = expf(gcs[dir * 64 + lane]); eg[cid * 64 + lane] = e; if (lane == 63) egl[cid] = e;
            }
        }
        __syncthreads();
    }
}

__device__ __forceinline__ void dn_scan(unsigned char* ws, int ch, int wv, int lane) {
    bf16* P = (bf16*)(ws + WS_P);
    const bf16* negw = (const bf16*)(ws + WS_NEGW); const bf16* uT = (const bf16*)(ws + WS_UT); const bf16* qhat = (const bf16*)(ws + WS_QH); const float* eg = (const float*)(ws + WS_EG);
    const float* egl = (const float*)(ws + WS_EGL); const bf16* Am = (const bf16*)(ws + WS_AM); const bf16* kdT = (const bf16*)(ws + WS_KDT);
    int b, h, dir;
    if (ch < 64) { b = 4 + (ch >> 3); h = (ch >> 1) & 3; dir = ch & 1; } else { const int c2 = ch - 64; b = c2 >> 3; h = (c2 >> 1) & 3; dir = c2 & 1; }
    int row0, S; batch_info(b, row0, S);
    const int N = S >> 6, chunk0 = row0 >> 6, e0 = 16 * wv;
    const int fr = lane & 15, fq = lane >> 4;
    f32x4 St[4];
#pragma unroll
    for (int dt = 0; dt < 4; ++dt) St[dt] = (f32x4){0.f, 0.f, 0.f, 0.f};
    for (int step = 0; step < N; ++step) {
        const int n = dir ? N - 1 - step : step; const int cgi = chunk0 + n; const size_t cid = ((size_t)cgi * 4 + h) * 2 + dir; const int rowc = cgi * 64;
        const bf16* nw = negw + cid * 4096; const bf16* Ab = Am + cid * 4096; const bf16* kd = kdT + cid * 4096;
        bf16x8 fw[4][2], fqh[4][2], fA[4][2], fk[4][2]; v2u ur[4]; f32x4 egv[4];
#pragma unroll
        for (int m = 0; m < 4; ++m) {
            const int tl = 16 * m + fr; const size_t trow = (size_t)(rowc + (dir ? 63 - tl : tl));
#pragma unroll
            for (int ks = 0; ks < 2; ++ks) { const int off = tl * 64 + 32 * ks + 8 * fq;
                fw[m][ks] = *(const bf16x8*)(nw + off); fA[m][ks] = *(const bf16x8*)(Ab + off); fk[m][ks] = *(const bf16x8*)(kd + off);
                fqh[m][ks] = *(const bf16x8*)(qhat + trow * 256 + h * 64 + 32 * ks + 8 * fq); }
            ur[m] = *(const v2u*)(uT + cid * 4096 + (e0 + fr) * 64 + 16 * m + 4 * fq);
            egv[m] = *(const f32x4*)(eg + cid * 64 + 16 * m + 4 * fq);
        }
        const float el = egl[cid];
        bf16x8 Sb[2], Vb[2];
#pragma unroll
        for (int ks = 0; ks < 2; ++ks) { v4u w; w.x = pk2(St[2 * ks][0], St[2 * ks][1]); w.y = pk2(St[2 * ks][2], St[2 * ks][3]); w.z = pk2(St[2 * ks + 1][0], St[2 * ks + 1][1]); w.w = pk2(St[2 * ks + 1][2], St[2 * ks + 1][3]); Sb[ks] = __builtin_bit_cast(bf16x8, w); }
        f32x4 vn[4], oo[4];
#pragma unroll
        for (int m = 0; m < 4; ++m) {
            f32x4 acc = {bflo(ur[m].x), bfhi(ur[m].x), bflo(ur[m].y), bfhi(ur[m].y)};
            acc = MFMA_BF16(fw[m][0], Sb[0], acc); acc = MFMA_BF16(fw[m][1], Sb[1], acc); vn[m] = acc;
            f32x4 o = {0.f, 0.f, 0.f, 0.f};
            o = MFMA_BF16(fqh[m][0], Sb[0], o); o = MFMA_BF16(fqh[m][1], Sb[1], o); oo[m] = o * egv[m];
        }
#pragma unroll
        for (int ks = 0; ks < 2; ++ks) { v4u w; w.x = pk2(vn[2 * ks][0], vn[2 * ks][1]); w.y = pk2(vn[2 * ks][2], vn[2 * ks][3]); w.z = pk2(vn[2 * ks + 1][0], vn[2 * ks + 1][1]); w.w = pk2(vn[2 * ks + 1][2], vn[2 * ks + 1][3]); Vb[ks] = __builtin_bit_cast(bf16x8, w); }
#pragma unroll
        for (int dt = 0; dt < 4; ++dt) { f32x4 s = St[dt] * el; s = MFMA_BF16(fk[dt][0], Vb[0], s); s = MFMA_BF16(fk[dt][1], Vb[1], s); St[dt] = s; }
#pragma unroll
        for (int m = 0; m < 4; ++m) {
            f32x4 o = oo[m]; o = MFMA_BF16(fA[m][0], Vb[0], o); o = MFMA_BF16(fA[m][1], Vb[1], o);
#pragma unroll
            for (int j = 0; j < 4; ++j) { const int tl = 16 * m + 4 * fq + j; const size_t trow = (size_t)(rowc + (dir ? 63 - tl : tl));
                P[trow * D_IN + 1536 + dir * 256 + h * 64 + e0 + fr] = f2bf(o[j]); }
        }
    }
}

__device__ __forceinline__ void dn_post(const bf16* P, bf16* mix, const float* ng  , int gw, int NGW, int lane) {
    const int c = 4 * lane;
    const f32x4 g4 = *(const f32x4*)(ng + (c & 63));
    for (int m = gw; m < M; m += NGW) {
        const bf16* pr = P + (size_t)m * D_IN;
        const v2u of = *(const v2u*)(pr + 1536 + c), ob = *(const v2u*)(pr + 1792 + c), zz = *(const v2u*)(pr + 2304 + c);
        f32x4 o = {bflo(of.x) + bflo(ob.x), bfhi(of.x) + bfhi(ob.x), bflo(of.y) + bflo(ob.y), bfhi(of.y) + bfhi(ob.y)};
        const f32x4 z = {bflo(zz.x), bfhi(zz.x), bflo(zz.y), bfhi(zz.y)};
        float ss = (o.x * o.x + o.y * o.y) + (o.z * o.z + o.w * o.w);
        ss += __shfl_xor(ss, 1); ss += __shfl_xor(ss, 2); ss += __shfl_xor(ss, 4); ss += __shfl_xor(ss, 8);
        const float r = 1.f / sqrtf(ss * (1.f / 64.f) + 1e-6f);
        f32x4 y;
#pragma unroll
        for (int e = 0; e < 4; ++e) y[e] = o[e] * r * g4[e] * (z[e] / (1.f + __expf(-z[e])));
        v2u w; w.x = pk2(y.x, y.y); w.y = pk2(y.z, y.w);
        *(v2u*)(mix + (size_t)m * D + 768 + c) = w;
    }
}


#ifndef MK_DEBUG
#define MK_DEBUG 0
#endif
#if MK_DEBUG
constexpr size_t WS_FLAG = WS_END;
__device__ __forceinline__ bool bad16(unsigned u) { return (u & 0x7f80u) >= (147u << 7); }
__device__ __forceinline__ bool bad32(unsigned u) { return (u & 0x7f800000u) >= (147u << 23); }
__global__ void __launch_bounds__(512) dbg_scan(const unsigned* buf, size_t nwords, int is16, unsigned* flag, int code) {
    bool bad = false;
    for (size_t i = (size_t)blockIdx.x * 512 + threadIdx.x; i < nwords; i += (size_t)gridDim.x * 512) { const unsigned u = buf[i]; bad |= is16 ? (bad16(u) || bad16(u >> 16)) : bad32(u); }
    if (bad) atomicMin(flag, (unsigned)code);
}
__global__ void __launch_bounds__(512) dbg_scan2(const unsigned short* buf, int rows, int ld, int c0, int nc, unsigned* flag, int code) {
    bool bad = false;
    for (size_t i = (size_t)blockIdx.x * 512 + threadIdx.x; i < (size_t)rows * nc; i += (size_t)gridDim.x * 512) { const size_t r = i / nc; const int c = (int)(i % nc); bad |= bad16(buf[r * ld + c0 + c]); }
    if (bad) atomicMin(flag, (unsigned)code);
}
__global__ void __launch_bounds__(512) dbg_fin(float* out, size_t n, const unsigned* flag) {
    const unsigned f = *flag; if (f == 0x7f7f7f7fu) return;
    const float v = sqrtf((float)(f + 1));
    for (size_t i = (size_t)blockIdx.x * 512 + threadIdx.x; i < n; i += (size_t)gridDim.x * 512) out[i] = v;
}
#endif
__global__ void __launch_bounds__(NTHREADS, 2) mega(Args a) {
    extern __shared__ __attribute__((aligned(16))) unsigned char lds_raw[];
    for (int p = a.ph_lo; p < a.ph_hi; ++p) {
        int tid = threadIdx.x; asm volatile("" : "+v"(tid));
        int bid = blockIdx.x; asm volatile("" : "+s"(bid));
        int G = gridDim.x; asm volatile("" : "+s"(G));
        unsigned char* ws = a.ws; asm volatile("" : "+s"(ws));
        float* X = a.out; asm volatile("" : "+s"(X));
        unsigned ldsoff = 0; asm volatile("" : "+s"(ldsoff));
        LAS unsigned char* lds = (LAS unsigned char*)lds_raw + ldsoff;
        const int lane = tid & 63, wave = __builtin_amdgcn_readfirstlane(tid >> 6);
        const int gw = bid * 8 + wave, NGW = G * 8;
        bf16* XN = (bf16*)(ws + WS_XN); bf16* P = (bf16*)(ws + WS_P); bf16* H = (bf16*)(ws + WS_H);
        const float* modbuf = (const float*)(ws + WS_MOD);
        int l = 0, pp = p;
        if (p >= 2) { l = (p - 2) / 9; pp = 2 + (p - 2) % 9; }
        const float* modl = modbuf + (size_t)l * NBATCH * 6144;
#ifndef PHMASK
#define PHMASK 0xFFFF
#endif
#define PH_ON(k) (((PHMASK) >> (k)) & 1)
        switch (pp) {
        case 0: if (!PH_ON(0)) break; convert_layer(a, ws, 0, lds, gw, NGW, wave, lane); __syncthreads(); mod_phase(a, ws, lds, tid, wave, lane, bid, G); break;
        case 1: if (!PH_ON(1)) break; ln_rows(a.in[0], a.in[1], true, X, a.in[4], a.in[5], modbuf, 0, XN, gw, NGW, lane); break;
        case 2: if (!PH_ON(2)) break; { pg8::Gemm g{XN, (const bf16*)(ws + WS_WIN), M, D_INP, D}; pg8::StaticOrder S; S.init(M, D_INP, G, bid); pg8::EpiP E{P};
                  pg8::gemm_phase<pg8::EpiP, pg8::StaticOrder, true, true>(lds, g, S, E, tid); } break;
        case 3: if (!PH_ON(3)) break; dn_prep(a, ws, l, lds, tid, wave, lane, bid, G); break;
        case 4: if (!PH_ON(4)) break; if (bid < NSCAN) { if (PH_ON(11)) dn_scan(ws, 2 * bid + (wave >> 2), wave & 3, lane); }
                else if (PH_ON(12)) { const int na = G - NSCAN, ab = bid - NSCAN;
#pragma unroll 1
                    for (int u = ab; u < 1280; u += na) attn_unit(P, XN, a.in[10] + l * 8, u, lds, tid, wave, lane);
                    conv_items(P, XN, a.in[9] + (size_t)l * 768, ab * NTHREADS + tid, na * NTHREADS); }
                break;
        case 5: if (!PH_ON(5)) break; dn_post(P, XN, a.in[16] + l * 64, gw, NGW, lane); break;
        case 6: if (!PH_ON(6)) break; { pg8::Gemm g{XN, (const bf16*)(ws + WS_WOUT), M, D, D}; pg8::StaticOrder S; S.init(M, D, G, bid); pg8::EpiRes E{X, modl + 2048, nullptr};
                  pg8::gemm_phase<pg8::EpiRes, pg8::StaticOrder, true, true>(lds, g, S, E, tid); } break;
        case 7: if (!PH_ON(7)) break; ln_rows(nullptr, nullptr, false, X, a.in[18] + l * D, a.in[19] + l * D, modl, 3072, XN, gw, NGW, lane); break;
        case 8: if (!PH_ON(8)) break; { pg8::Gemm g{XN, (const bf16*)(ws + WS_W1), M, D_FF, D}; pg8::StaticOrder S; S.init(M, D_FF, G, bid); pg8::EpiH E{H, a.in[21] + (size_t)l * D_FF};
                  pg8::gemm_phase<pg8::EpiH, pg8::StaticOrder, true, true>(lds, g, S, E, tid); } break;
        case 9: if (!PH_ON(9)) break; { pg8::Gemm g{H, (const bf16*)(ws + WS_W2), M, D, D_FF}; pg8::StaticOrder S; S.init(M, D, G, bid); pg8::EpiRes E{X, modl + 5120, a.in[23] + (size_t)l * D};
                  pg8::gemm_phase<pg8::EpiRes, pg8::StaticOrder, true, true>(lds, g, S, E, tid); } break;
        case 10: if (!PH_ON(10)) break; if (l < DEPTH - 1) { ln_rows(nullptr, nullptr, false, X, a.in[24] + l * D, a.in[25] + l * D, modl + (size_t)NBATCH * 6144, 0, XN, gw, NGW, lane); convert_layer(a, ws, l + 1, lds, gw, NGW, wave, lane); }
                 else ln_rows(nullptr, nullptr, false, X, a.in[24] + l * D, a.in[25] + l * D, nullptr, 0, nullptr, gw, NGW, lane);
                 break;
        }
        if (p + 1 < a.ph_hi) cg::this_grid().sync();
    }
}
constexpr int NPHASES = 2 + 9 * DEPTH;

extern "C" void kernel_launch(void* const* d_in, const int* in_sizes, int n_in, void* d_out, int out_size, void* d_ws, size_t ws_size, hipStream_t stream) {
    static int grid = 0;
    if (grid == 0) {
        if (n_in != 26 || out_size != M * D || ws_size < WS_END) { fprintf(stderr, "kernel_launch: unexpected sizes n_in %d out %d ws %zu\n", n_in, out_size, ws_size); grid = -1; return; }
        int dev = 0, cus = 0, per_cu = 0;
        hipGetDevice(&dev); hipDeviceGetAttribute(&cus, hipDeviceAttributeMultiprocessorCount, dev);
        if (hipFuncSetAttribute((const void*)mega, hipFuncAttributeMaxDynamicSharedMemorySize, LDS_BYTES) != hipSuccess) { fprintf(stderr, "kernel_launch: hipFuncSetAttribute failed\n"); grid = -1; return; }
        if (hipOccupancyMaxActiveBlocksPerMultiprocessor(&per_cu, (const void*)mega, NTHREADS, LDS_BYTES) != hipSuccess || per_cu < 1) { fprintf(stderr, "kernel_launch: occupancy query says %d\n", per_cu); per_cu = 1; }
        (void)hipGetLastError();
        grid = cus * 1;
        if (grid <= NSCAN + 8) { fprintf(stderr, "kernel_launch: grid %d too small\n", grid); grid = -1; return; }
    }
    if (grid < 0) return;
    Args a{};
    for (int i = 0; i < 26; ++i) a.in[i] = (const float*)d_in[i];
    a.out = (float*)d_out; a.ws = (unsigned char*)d_ws;
#if MK_MULTI
#if MK_DEBUG
    unsigned* flag = (unsigned*)((unsigned char*)d_ws + WS_FLAG);
    (void)hipMemsetAsync(flag, 0x7f, 4, stream);
    unsigned char* wsb = (unsigned char*)d_ws;
#define DSCAN(off, bytes, is16, code) hipLaunchKernelGGL(dbg_scan, dim3(1024), dim3(512), 0, stream, (const unsigned*)(wsb + (off)), (size_t)(bytes) / 4, is16, flag, code)
#define DSCANX(code) hipLaunchKernelGGL(dbg_scan, dim3(1024), dim3(512), 0, stream, (const unsigned*)d_out, (size_t)M * D, 0, flag, code)
#endif
    for (int p = 0; p < NPHASES; ++p) { a.ph_lo = p; a.ph_hi = p + 1; hipLaunchKernelGGL(mega, dim3(grid), dim3(NTHREADS), LDS_BYTES, stream, a);
#if MK_DEBUG
        const int pp = p < 2 ? p : 2 + (p - 2) % 9;
        const int code = p * 4;
        switch (pp) {
        case 0: DSCAN(WS_MOD, DEPTH * NBATCH * 6144 * 4, 0, code); DSCAN(WS_WIN, WS_P - WS_WIN - MiB / 2, 1, code + 1); break;
        case 1: case 7: case 10: DSCANX(code); DSCAN(WS_XN, (size_t)M * D * 2, 1, code + 1); break;
        case 2: DSCAN(WS_P, (size_t)M * D_IN * 2, 1, code); break;
        case 3: DSCAN(WS_NEGW, 80 * MiB, 1, code); DSCAN(WS_UT, 80 * MiB, 1, code + 1); DSCAN(WS_AM, 160 * MiB, 1, code + 2); DSCAN(WS_QH, 40 * MiB, 1, code + 3); break;
        case 4: hipLaunchKernelGGL(dbg_scan2, dim3(1024), dim3(512), 0, stream, (const unsigned short*)(wsb + WS_XN), M, D, 0, 256, flag, code);
                hipLaunchKernelGGL(dbg_scan2, dim3(1024), dim3(512), 0, stream, (const unsigned short*)(wsb + WS_XN), M, D, 256, 512, flag, code + 1);
                hipLaunchKernelGGL(dbg_scan2, dim3(1024), dim3(512), 0, stream, (const unsigned short*)(wsb + WS_P), M, D_IN, 1536, 512, flag, code + 2);
                hipLaunchKernelGGL(dbg_scan2, dim3(1024), dim3(512), 0, stream, (const unsigned short*)(wsb + WS_XN), M, D, 768, 256, flag, code + 3); break;
        case 5: DSCAN(WS_XN, (size_t)M * D * 2, 1, code); break;
        case 6: case 9: DSCANX(code); break;
        case 8: DSCAN(WS_H, (size_t)M * D_FF * 2, 1, code); break;
        }
#endif
    }
#if MK_DEBUG
    hipLaunchKernelGGL(dbg_fin, dim3(1024), dim3(512), 0, stream, (float*)d_out, (size_t)M * D, flag);
#endif
#else
    a.ph_lo = 0; a.ph_hi = NPHASES;
    void* args[] = {&a};
    hipError_t e = hipLaunchCooperativeKernel((const void*)mega, dim3(grid), dim3(NTHREADS), args, LDS_BYTES, stream);
    if (e != hipSuccess) fprintf(stderr, "cooperative launch failed: %s (grid %d)\n", hipGetErrorString(e), grid);
#endif
}
```

```cpp
#include <hip/hip_runtime.h>
#include <hip/hip_cooperative_groups.h>
#include <cstdio>
#include <cstdint>
namespace cg = cooperative_groups;

#ifndef MK_MULTI
#define MK_MULTI 0
#endif

constexpr int D = 1024, DEPTH = 4;
constexpr int M_P = 4 * 4096, M_S = 8 * 8192, M = M_P + M_S;
constexpr int NBATCH = 12;
constexpr int D_IN = 2576, D_INP = 2816, D_FF = 4096;
constexpr int NCHUNK = M / 64;
constexpr float ALPHA = 1.681792830507429f;
__host__ __device__ __forceinline__ int batch_of_row(int m) { return m < M_P ? (m >> 12) : 4 + ((m - M_P) >> 13); }
__host__ __device__ __forceinline__ void batch_info(int b, int& row0, int& S) { if (b < 4) { row0 = b << 12; S = 4096; } else { row0 = M_P + ((b - 4) << 13); S = 8192; } }
namespace pg8 {
#define PG8_LAS __attribute__((address_space(3)))
typedef unsigned short bf16_t;
typedef short bf16x8 __attribute__((ext_vector_type(8)));
typedef float f32x4 __attribute__((ext_vector_type(4)));
typedef unsigned u32x4 __attribute__((ext_vector_type(4)));
constexpr int BM = 256, BK = 64, HALF = 128, HTB = HALF * BK * 2  , STAGE_BYTES = 8 * HTB, NXCD = 8, WGM = 8;

__host__ __device__ __forceinline__ int lds_byte(int r, int c) { const int st = (r >> 4) * 2 + (c >> 5), rr = r & 15, cc = c & 31, ob = rr * 64 + cc * 2; return st * 1024 + (ob ^ (((ob >> 9) & 1) << 5)); }
__host__ __device__ __forceinline__ void stage_rc(int b, int& R, int& C) { const int st = b / 1024, sb = b % 1024, swz = sb ^ (((sb >> 9) & 1) << 5); R = (st >> 1) * 16 + swz / 64; C = (st & 1) * 32 + (swz % 64) / 2; }
__host__ __device__ __forceinline__ int perm32(int rho) { const int n = rho >> 4, i = rho & 15; return 8 * (i >> 2) + 4 * n + (i & 3); }

struct Unit { int pm, pn; };
struct Gemm { const bf16_t* A; const bf16_t* Bt; int M, N, K; };

struct StaticOrder {
    int nM, nN, nwg, G, c;
    __host__ __device__ void init(int M, int N, int G_, int c_) { nM = M / BM; nN = N / BM; nwg = nM * nN; G = G_; c = c_; }
    __host__ __device__ bool next(int i, Unit& u) const {
        const long L = (long)i * G + c; if (L >= nwg) return false;
        int wgid = (int)L; { const int q = nwg / NXCD, r = nwg % NXCD, xcd = wgid % NXCD, off = wgid / NXCD; wgid = (xcd < r ? xcd * (q + 1) : r * (q + 1) + (xcd - r) * q) + off; }
        const int nig = WGM * nN, gid = wgid / nig, fm = gid * WGM, gsz = (nM - fm) < WGM ? (nM - fm) : WGM;
        u.pm = fm + ((wgid % nig) % gsz); u.pn = (wgid % nig) / gsz; return true;
    }
    __device__ __forceinline__ void a_ready(const Unit&) const {}
    __device__ __forceinline__ void done(const Unit&) const {}
};

typedef __bf16 bf16x2_t __attribute__((ext_vector_type(2)));
typedef float f32x2_t __attribute__((ext_vector_type(2)));
__device__ __forceinline__ unsigned cvt_pk_bf16(float lo, float hi) { const f32x2_t v = {lo, hi}; const bf16x2_t b = __builtin_convertvector(v, bf16x2_t); return __builtin_bit_cast(unsigned, b); }
typedef float f32x2 __attribute__((ext_vector_type(2)));
struct EpiP {
    static constexpr bool PERM = true, AFTER_DRAIN = false;
    bf16_t* O;
    __device__ __forceinline__ void operator()(const f32x4 (&acc)[2][2][4][2], const Unit& u, int wr, int wc, int fr, int fq) const {
        const int row0 = u.pm * BM + wr * 64 + fr; const int col0 = u.pn * BM + wc * 32 + 8 * fq;
#pragma unroll
        for (int ai = 0; ai < 2; ++ai)
#pragma unroll
            for (int m = 0; m < 4; ++m) { bf16_t* rowp = O + (size_t)(row0 + ai * HALF + m * 16) * 2576 + col0;
#pragma unroll
                for (int bj = 0; bj < 2; ++bj) { if (col0 + bj * HALF < 2576) { const f32x4 v0 = acc[ai][bj][m][0], v1 = acc[ai][bj][m][1];
                    u32x4 w; w.x = cvt_pk_bf16(v0[0], v0[1]); w.y = cvt_pk_bf16(v0[2], v0[3]); w.z = cvt_pk_bf16(v1[0], v1[1]); w.w = cvt_pk_bf16(v1[2], v1[3]);
                    *(u32x4*)(rowp + bj * HALF) = w; } } }
    }
};
struct EpiH {
    static constexpr bool PERM = true, AFTER_DRAIN = false;
    bf16_t* O; const float* bias;
    __device__ __forceinline__ void operator()(const f32x4 (&acc)[2][2][4][2], const Unit& u, int wr, int wc, int fr, int fq) const {
        const int row0 = u.pm * BM + wr * 64 + fr; const int col0 = u.pn * BM + wc * 32 + 8 * fq;
        f32x4 bv[2][2];
#pragma unroll
        for (int bj = 0; bj < 2; ++bj)
#pragma unroll
            for (int n = 0; n < 2; ++n) bv[bj][n] = *(const f32x4*)(bias + col0 + bj * HALF + 4 * n);
#pragma unroll
        for (int ai = 0; ai < 2; ++ai)
#pragma unroll
            for (int m = 0; m < 4; ++m) { bf16_t* rowp = O + (size_t)(row0 + ai * HALF + m * 16) * 4096 + col0;
#pragma unroll
                for (int bj = 0; bj < 2; ++bj) { f32x4 v0 = acc[ai][bj][m][0] + bv[bj][0], v1 = acc[ai][bj][m][1] + bv[bj][1];
                    v0 = __builtin_elementwise_max(v0, (f32x4){0.f, 0.f, 0.f, 0.f}); v1 = __builtin_elementwise_max(v1, (f32x4){0.f, 0.f, 0.f, 0.f}); v0 = v0 * v0; v1 = v1 * v1;
                    u32x4 w; w.x = cvt_pk_bf16(v0[0], v0[1]); w.y = cvt_pk_bf16(v0[2], v0[3]); w.z = cvt_pk_bf16(v1[0], v1[1]); w.w = cvt_pk_bf16(v1[2], v1[3]);
                    *(u32x4*)(rowp + bj * HALF) = w; } }
    }
};
struct EpiRes {
    static constexpr bool PERM = false, AFTER_DRAIN = false;
    float* X; const float* gate  ; const float* bias  ;
    const float* stats  ; const float* gam; const float* bet;
    const float* src_p; const float* src_s;
    __device__ __forceinline__ void operator()(const f32x4 (&acc)[2][2][4][2], const Unit& u, int wr, int wc, int fr, int fq) const {
        const int row0 = u.pm * BM + wr * 64 + fr; const int col0 = u.pn * BM + wc * 32 + 4 * fq;
        const float* gb = gate + (size_t)batch_of_row(u.pm * BM) * 6144;
        const float* XS = src_p ? (u.pm * BM < M_P ? src_p : src_s - (size_t)M_P * 1024) : X;
#pragma unroll
        for (int bj = 0; bj < 2; ++bj) {
            f32x4 av[2], gv[2], cv[2];
#pragma unroll
            for (int n = 0; n < 2; ++n) { const int c = col0 + bj * HALF + n * 16;
                gv[n] = *(const f32x4*)(gb + c) + 1.0f;
                const f32x4 bv = bias ? *(const f32x4*)(bias + c) : (f32x4){0.f, 0.f, 0.f, 0.f};
                if (stats) { av[n] = *(const f32x4*)(gam + c) * ALPHA; cv[n] = *(const f32x4*)(bet + c) * ALPHA + gv[n] * bv; }
                else { av[n] = (f32x4){ALPHA, ALPHA, ALPHA, ALPHA}; cv[n] = gv[n] * bv; } }
#pragma unroll
            for (int ai = 0; ai < 2; ++ai)
#pragma unroll
                for (int mp = 0; mp < 2; ++mp) {
                    f32x4 xo[2][2]; f32x2 st[2];
#pragma unroll
                    for (int mm = 0; mm < 2; ++mm) { const int r = row0 + ai * HALF + (2 * mp + mm) * 16; const float* xp = XS + (size_t)r * 1024 + col0 + bj * HALF;
                        xo[mm][0] = *(const f32x4*)xp; xo[mm][1] = *(const f32x4*)(xp + 16);
                        st[mm] = stats ? *(const f32x2*)(stats + 2 * (size_t)r) : (f32x2){0.f, 1.f}; }
#pragma unroll
                    for (int mm = 0; mm < 2; ++mm) { const int m = 2 * mp + mm; const int r = row0 + ai * HALF + m * 16; float* xp = X + (size_t)r * 1024 + col0 + bj * HALF;
#pragma unroll
                        for (int n = 0; n < 2; ++n)
                            *(f32x4*)(xp + n * 16) = ((xo[mm][n] - st[mm].x) * st[mm].y) * av[n] + gv[n] * acc[ai][bj][m][n] + cv[n]; }
                    asm volatile("" ::: "memory");
                }
        }
    }
};
template <class Epi, class Sched, bool ALIGN_EPI = false, bool SP2 = false>
__device__ __forceinline__ void gemm_phase(PG8_LAS unsigned char* lds, const Gemm g, const Sched& S, const Epi& E, const int tid) {
    const int wid = __builtin_amdgcn_readfirstlane(tid >> 6), lane = tid & 63, wr = wid >> 2, wc = wid & 3, fr = lane & 15, fq = lane >> 4;
    const int K = g.K, nt = K / BK;
    unsigned voffA[2], voffB[2];
#pragma unroll
    for (int i = 0; i < 2; ++i) { int R, C; stage_rc(tid * 16 + i * 8192, R, C); const int Rb = Epi::PERM ? ((R & ~31) + perm32(R & 31)) : R;
        voffA[i] = (unsigned)(R * K + C) * 2u; voffB[i] = (unsigned)(Rb * K + C) * 2u; }
    const size_t kstep = (size_t)(BK * 2);
    const size_t hstep = (size_t)HALF * K * 2;
    const size_t tstep = 2 * hstep;
    const unsigned ldsw = (unsigned)wid * 1024u;
    const int aoff = lds_byte(wr * 64 + fr, fq * 8), boff = lds_byte(wc * 32 + fr, fq * 8);
#define PG8_SA(b, h) (((b) * 2 + (h)) * HTB)
#define PG8_SB(b, h) ((4 + (b) * 2 + (h)) * HTB)
#define PG8_STAGE(bufoff, gbase, voff) do { _Pragma("unroll") for (int _i = 0; _i < 2; ++_i) \
        __builtin_amdgcn_global_load_lds((const unsigned*)((const char*)(gbase) + (voff)[_i]), (PG8_LAS unsigned*)(lds + (bufoff) + ldsw + _i * 8192), 16, 0, 0); } while (0)
#define PG8_LDA(dst, b, h) do { _Pragma("unroll") for (int m = 0; m < 4; ++m) _Pragma("unroll") for (int k = 0; k < 2; ++k) dst[m][k] = *(const PG8_LAS bf16x8*)(lds + PG8_SA(b, h) + aoff + m * 2048 + k * 1024); } while (0)
#define PG8_LDB(dst, b, h) do { _Pragma("unroll") for (int n = 0; n < 2; ++n) _Pragma("unroll") for (int k = 0; k < 2; ++k) dst[n][k] = *(const PG8_LAS bf16x8*)(lds + PG8_SB(b, h) + boff + n * 2048 + k * 1024); } while (0)
#define PG8_MMA(ai, bj, At, Bt) do { __builtin_amdgcn_s_setprio(1); _Pragma("unroll") for (int m = 0; m < 4; ++m) _Pragma("unroll") for (int n = 0; n < 2; ++n) _Pragma("unroll") for (int k = 0; k < 2; ++k) \
        acc[ai][bj][m][n] = __builtin_amdgcn_mfma_f32_16x16x32_bf16(Bt[n][k], At[m][k], acc[ai][bj][m][n], 0, 0, 0); __builtin_amdgcn_s_setprio(0); } while (0)
#define PG8_WAIT_V(n) asm volatile("s_waitcnt vmcnt(" #n ")" ::: "memory")
#define PG8_WAIT_L(n) asm volatile("s_waitcnt lgkmcnt(" #n ")" ::: "memory")
#define PG8_BAR __builtin_amdgcn_s_barrier()
#define PG8_SCHED __builtin_amdgcn_sched_barrier(0)
    Unit cur, nxt; int ui = 0;
    if (!S.next(0, cur)) return;
    f32x4 acc[2][2][4][2];
#pragma unroll
    for (int a = 0; a < 2; ++a)
#pragma unroll
        for (int b = 0; b < 2; ++b)
#pragma unroll
            for (int m = 0; m < 4; ++m)
#pragma unroll
                for (int n = 0; n < 2; ++n) acc[a][b][m][n] = (f32x4){0.f, 0.f, 0.f, 0.f};
    bf16x8 At[4][2], B0[2][2], B1[2][2];
    const char* cA = (const char*)g.A + (size_t)cur.pm * tstep; const char* cB = (const char*)g.Bt + (size_t)cur.pn * tstep;
    S.a_ready(cur);
    if constexpr (SP2) {
        PG8_STAGE(PG8_SB(0, 0), cB, voffB); PG8_STAGE(PG8_SB(0, 1), cB + hstep, voffB); PG8_STAGE(PG8_SA(0, 0), cA, voffA); PG8_STAGE(PG8_SA(0, 1), cA + hstep, voffA);
        if (wr == 1) PG8_BAR;
        PG8_WAIT_V(2); PG8_BAR;
        PG8_STAGE(PG8_SB(1, 0), cB + kstep, voffB); PG8_STAGE(PG8_SA(1, 0), cA + kstep, voffA); PG8_STAGE(PG8_SB(1, 1), cB + hstep + kstep, voffB);
        PG8_WAIT_V(6); PG8_BAR;
    } else {
        PG8_STAGE(PG8_SB(0, 0), cB, voffB); PG8_STAGE(PG8_SA(0, 0), cA, voffA); PG8_STAGE(PG8_SB(0, 1), cB + hstep, voffB); PG8_STAGE(PG8_SA(0, 1), cA + hstep, voffA);
        if (wr == 1) PG8_BAR;
        PG8_WAIT_V(4); PG8_BAR;
        PG8_STAGE(PG8_SB(1, 0), cB + kstep, voffB); PG8_STAGE(PG8_SA(1, 0), cA + kstep, voffA); PG8_STAGE(PG8_SB(1, 1), cB + hstep + kstep, voffB);
        PG8_WAIT_V(6); PG8_BAR;
    }
    for (;;) {
        const bool has_next = S.next(ui + 1, nxt);
        const char* nA = has_next ? (const char*)g.A + (size_t)nxt.pm * tstep : cA; const char* nB = has_next ? (const char*)g.Bt + (size_t)nxt.pn * tstep : cB;
        for (int t = 0; t < nt; t += 2) {
            const bool last = (t == nt - 2);
            const char* a1 = cA + (size_t)(t + 1) * kstep;
            const char* a2 = last ? nA : cA + (size_t)(t + 2) * kstep; const char* b2 = last ? nB : cB + (size_t)(t + 2) * kstep;
            const char* a3 = a2 + kstep; const char* b3 = b2 + kstep;
            if (last && has_next) S.a_ready(nxt);
            if constexpr (SP2) {
            PG8_LDB(B0, 0, 0); PG8_LDB(B1, 0, 1); PG8_SCHED; PG8_LDA(At, 0, 0); PG8_STAGE(PG8_SA(1, 1), a1 + hstep, voffA);
            PG8_WAIT_V(8); PG8_WAIT_L(0); PG8_BAR; PG8_MMA(0, 0, At, B0); PG8_MMA(0, 1, At, B1); PG8_BAR; PG8_SCHED;
            PG8_LDA(At, 0, 1); PG8_STAGE(PG8_SB(0, 0), b2, voffB); PG8_STAGE(PG8_SB(0, 1), b2 + hstep, voffB); PG8_STAGE(PG8_SA(0, 0), a2, voffA);
            PG8_WAIT_V(8); PG8_WAIT_L(0); PG8_BAR; PG8_MMA(1, 0, At, B0); PG8_MMA(1, 1, At, B1); PG8_BAR; PG8_SCHED;
            PG8_LDB(B0, 1, 0); PG8_LDB(B1, 1, 1); PG8_SCHED; PG8_LDA(At, 1, 0); PG8_STAGE(PG8_SA(0, 1), a2 + hstep, voffA);
            PG8_WAIT_V(8); PG8_WAIT_L(0); PG8_BAR; PG8_MMA(0, 0, At, B0); PG8_MMA(0, 1, At, B1); PG8_BAR; PG8_SCHED;
            PG8_LDA(At, 1, 1); PG8_STAGE(PG8_SB(1, 0), b3, voffB); PG8_STAGE(PG8_SB(1, 1), b3 + hstep, voffB); PG8_STAGE(PG8_SA(1, 0), a3, voffA);
            PG8_WAIT_V(8); PG8_WAIT_L(0); PG8_BAR; PG8_MMA(1, 0, At, B0); PG8_MMA(1, 1, At, B1); PG8_BAR; PG8_SCHED;
            } else {
            PG8_LDB(B0, 0, 0); PG8_SCHED; PG8_LDA(At, 0, 0); PG8_STAGE(PG8_SA(1, 1), a1 + hstep, voffA);
            PG8_WAIT_L(8); PG8_BAR; PG8_WAIT_L(0); PG8_MMA(0, 0, At, B0); PG8_BAR; PG8_SCHED;
            PG8_LDB(B1, 0, 1); PG8_STAGE(PG8_SB(0, 0), b2, voffB);
            PG8_BAR; PG8_WAIT_L(0); PG8_MMA(0, 1, At, B1); PG8_BAR;
            PG8_LDA(At, 0, 1); PG8_STAGE(PG8_SA(0, 0), a2, voffA);
            PG8_BAR; PG8_WAIT_L(0); PG8_MMA(1, 0, At, B0); PG8_BAR; PG8_SCHED;
            PG8_STAGE(PG8_SB(0, 1), b2 + hstep, voffB);
            PG8_WAIT_V(6); PG8_BAR; PG8_MMA(1, 1, At, B1); PG8_BAR;
            PG8_LDB(B0, 1, 0); PG8_SCHED; PG8_LDA(At, 1, 0); PG8_STAGE(PG8_SA(0, 1), a2 + hstep, voffA);
            PG8_WAIT_L(8); PG8_BAR; PG8_WAIT_L(0); PG8_MMA(0, 0, At, B0); PG8_BAR; PG8_SCHED;
            PG8_LDB(B1, 1, 1); PG8_STAGE(PG8_SB(1, 0), b3, voffB);
            PG8_BAR; PG8_WAIT_L(0); PG8_MMA(0, 1, At, B1); PG8_BAR;
            PG8_LDA(At, 1, 1); PG8_STAGE(PG8_SA(1, 0), a3, voffA);
            PG8_BAR; PG8_WAIT_L(0); PG8_MMA(1, 0, At, B0); PG8_BAR; PG8_SCHED;
            PG8_STAGE(PG8_SB(1, 1), b3 + hstep, voffB);
            PG8_WAIT_V(6); PG8_BAR; PG8_MMA(1, 1, At, B1); PG8_BAR;
            }
        }
        if constexpr (ALIGN_EPI) { if (wr == 0) PG8_BAR; }
        if constexpr (!Epi::AFTER_DRAIN) { E(acc, cur, wr, wc, fr, fq); S.done(cur); }
        if (!has_next) break;
#pragma unroll
        for (int a = 0; a < 2; ++a)
#pragma unroll
            for (int b = 0; b < 2; ++b)
#pragma unroll
                for (int m = 0; m < 4; ++m)
#pragma unroll
                    for (int n = 0; n < 2; ++n) acc[a][b][m][n] = (f32x4){0.f, 0.f, 0.f, 0.f};
        cur = nxt; cA = nA; cB = nB; ++ui;
        if constexpr (ALIGN_EPI) { if (wr == 1) PG8_BAR; }
    }
    PG8_WAIT_V(0);
    if constexpr (!ALIGN_EPI) { if (wr == 0) PG8_BAR; }
    PG8_BAR;
    if constexpr (Epi::AFTER_DRAIN) { E.fused(acc, cur, wr, wc, fr, fq, lds, wid, lane); S.done(cur); }
#undef PG8_SA
#undef PG8_SB
#undef PG8_STAGE
#undef PG8_LDA
#undef PG8_LDB
#undef PG8_MMA
#undef PG8_WAIT_V
#undef PG8_WAIT_L
#undef PG8_BAR
#undef PG8_SCHED
}
}

#define GAS __attribute__((address_space(1)))
#define LAS __attribute__((address_space(3)))
typedef unsigned short bf16;
typedef unsigned v4u __attribute__((ext_vector_type(4)));
typedef unsigned v2u __attribute__((ext_vector_type(2)));
typedef float f32x4 __attribute__((ext_vector_type(4)));
typedef short bf16x8 __attribute__((ext_vector_type(8)));
constexpr int NTHREADS = 512;
constexpr int LDS_BYTES = 147456 + 64;
constexpr int NSCAN = 96;

constexpr size_t MiB = 1u << 20;
constexpr size_t WS_MOD = 0;
constexpr size_t WS_EGL = WS_MOD + (size_t)DEPTH * NBATCH * 6144 * 4;
constexpr size_t WS_STATS = 1310720;
constexpr size_t WS_WIN = 2 * MiB, WS_WOUT = WS_WIN + (size_t)D_INP * D * 2, WS_W1 = WS_WOUT + (size_t)D * D * 2, WS_W2 = WS_W1 + (size_t)D_FF * D * 2;
constexpr size_t WS_P = 26 * MiB;
constexpr size_t WS_H = 26 * MiB;
constexpr size_t WS_DNC = 429 * MiB;
constexpr size_t WS_QH = 749 * MiB, WS_EG = 789 * MiB;
constexpr size_t WS_WX = 792 * MiB;
constexpr size_t WS_END = 863 * MiB;
constexpr size_t WS_XN = 864 * MiB;
static_assert(WS_W2 + (size_t)D * D_FF * 2 <= WS_P && WS_P + (size_t)M * D_IN * 2 <= WS_DNC && WS_DNC + (size_t)NCHUNK * 8 * 32768 <= WS_QH && WS_EG + (size_t)NCHUNK * 8 * 64 * 4 <= WS_END && WS_H + (size_t)M * D_FF * 2 <= WS_XN && WS_XN + (size_t)M * D * 2 <= 1024 * MiB && WS_EGL + NCHUNK * 8 * 4 <= WS_STATS && WS_STATS + (size_t)M * 8 <= 1966080 && 1966080 + 16384 <= WS_WIN && WS_END + 64 <= WS_XN, "ws map");

__device__ __forceinline__ float bflo(unsigned u) { return __builtin_bit_cast(float, u << 16); }
__device__ __forceinline__ float bfhi(unsigned u) { return __builtin_bit_cast(float, u & 0xffff0000u); }
__device__ __forceinline__ float bf1(bf16 u) { return __builtin_bit_cast(float, (unsigned)u << 16); }
__device__ __forceinline__ unsigned pk2(float lo, float hi) { return pg8::cvt_pk_bf16(lo, hi); }
__device__ __forceinline__ bf16 f2bf(float v) { return __builtin_bit_cast(unsigned short, (__bf16)v); }
__device__ __forceinline__ float wave_sum(float v) {
#pragma unroll
    for (int o = 1; o < 64; o <<= 1) v += __shfl_xor(v, o);
    return v;
}
constexpr size_t LAYER_W_BYTES = (size_t)D_INP * D * 2 + (size_t)D * D * 2 + 2 * (size_t)D_FF * D * 2;
static_assert(WS_WX + 3 * LAYER_W_BYTES <= WS_END, "ws map (weights)");
__host__ __device__ __forceinline__ size_t wbase(int l) { return l == 0 ? 0 : (WS_WX - WS_WIN) + (size_t)(l - 1) * LAYER_W_BYTES; }
__device__ __forceinline__ int dmap(int p) { return 16 * ((p >> 2) & 1) + 4 * (p >> 3) + (p & 3); }
__device__ __forceinline__ int ppos(int d) { return 8 * ((d >> 2) & 3) + 4 * (d >> 4) + (d & 3); }
#define MFMA_BF16(a, b, c) __builtin_amdgcn_mfma_f32_16x16x32_bf16((a), (b), (c), 0, 0, 0)

struct Args { const float* in[26]; float* out; unsigned char* ws; int ph_lo, ph_hi; };

__device__ __forceinline__ void transpose_item(const float* W, int K, int N, bf16* WT, LAS float* scr, int item, int nblk, int lane) {
    const int kb = item / nblk, nb = item % nblk, k0 = 64 * kb, n0 = 32 * nb;
    const int nn = n0 + (lane & 31);
#pragma unroll 8
    for (int i = 0; i < 32; ++i) { const int kk = 2 * i + (lane >> 5); scr[kk * 33 + (lane & 31)] = nn < N ? W[(size_t)(k0 + kk) * N + nn] : 0.f; }
    asm volatile("s_waitcnt lgkmcnt(0)" ::: "memory");
    const int c = lane & 7;
#pragma unroll
    for (int j = 0; j < 4; ++j) { const int n = (lane >> 3) + 8 * j; const LAS float* s = scr + (8 * c) * 33 + n;
        v4u o; o.x = pk2(s[0 * 33], s[1 * 33]); o.y = pk2(s[2 * 33], s[3 * 33]); o.z = pk2(s[4 * 33], s[5 * 33]); o.w = pk2(s[6 * 33], s[7 * 33]);
        *(v4u*)(WT + (size_t)(n0 + n) * K + k0 + 8 * c) = o; }
    asm volatile("s_waitcnt lgkmcnt(0)" ::: "memory");
}
__device__ __forceinline__ void convert_layer(const Args& a, unsigned char* ws, int l, LAS unsigned char* lds, int gw, int NGW, int wave, int lane) {
    LAS float* scr = (LAS float*)(lds + wave * 16384);
    const float* Win = a.in[8] + (size_t)l * D * D_IN; const float* Wout = a.in[17] + (size_t)l * D * D;
    const float* W1 = a.in[20] + (size_t)l * D * D_FF; const float* W2 = a.in[22] + (size_t)l * D_FF * D;
    const size_t wb = wbase(l);
    bf16* WinT = (bf16*)(ws + WS_WIN + wb); bf16* WoutT = (bf16*)(ws + WS_WOUT + wb); bf16* W1T = (bf16*)(ws + WS_W1 + wb); bf16* W2T = (bf16*)(ws + WS_W2 + wb);
    constexpr int I_IN = 16 * 88, I_OUT = 16 * 32, I_1 = 16 * 128, I_2 = 64 * 32;
    for (int it = gw; it < I_IN + I_OUT + I_1 + I_2; it += NGW) {
        int r = it;
        if (r < I_IN) { transpose_item(Win, D, D_IN, WinT, scr, r, 88, lane); continue; } r -= I_IN;
        if (r < I_OUT) { transpose_item(Wout, D, D, WoutT, scr, r, 32, lane); continue; } r -= I_OUT;
        if (r < I_1) { transpose_item(W1, D, D_FF, W1T, scr, r, 128, lane); continue; } r -= I_1;
        transpose_item(W2, D_FF, D, W2T, scr, r, 32, lane);
    }
}
__device__ __forceinline__ void mod_phase(const Args& a, unsigned char* ws, LAS unsigned char* lds, int tid, int wave, int lane, int bid, int G) {
    LAS float* sc = (LAS float*)lds;
    LAS float* red = (LAS float*)(lds + 49152);
    float* modbuf = (float*)(ws + WS_MOD);
    for (int i = tid; i < NBATCH * 1024; i += NTHREADS) { const int b = i >> 10, k = i & 1023; const float c = b < 4 ? a.in[2][b * 1024 + k] : a.in[3][(b - 4) * 1024 + k]; sc[i] = c / (1.f + __expf(-c)); }
    __syncthreads();
    for (int unit = bid; unit < DEPTH * 96; unit += G) {
        const int l = unit / 96, jb = unit % 96;
        const float* W = a.in[6] + (size_t)l * D * 6144 + jb * 64 + lane;
        float acc[NBATCH];
#pragma unroll
        for (int b = 0; b < NBATCH; ++b) acc[b] = 0.f;
#pragma unroll 4
        for (int k = wave * 128; k < wave * 128 + 128; ++k) { const float w = W[(size_t)k * 6144];
#pragma unroll
            for (int b = 0; b < NBATCH; ++b) acc[b] += sc[b * 1024 + k] * w; }
#pragma unroll
        for (int b = 0; b < NBATCH; ++b) red[(wave * NBATCH + b) * 64 + lane] = acc[b];
        __syncthreads();
        for (int i = tid; i < NBATCH * 64; i += NTHREADS) { const int b = i >> 6, ln = i & 63; float s = 0.f;
#pragma unroll
            for (int w = 0; w < 8; ++w) s += red[(w * NBATCH + b) * 64 + ln];
            modbuf[(size_t)(l * NBATCH + b) * 6144 + jb * 64 + ln] = s + a.in[7][l * 6144 + jb * 64 + ln]; }
        __syncthreads();
    }
}

__device__ __forceinline__ void ln_rows(const float* xp, const float* xs, bool in_mode, float* X, const float* gam, const float* bet, const float* modl, int sh_off, bf16* XN, float* stats  , int gw, int NGW, int lane) {
#define LN_SRC(m_) (in_mode ? ((m_) < M_P ? xp + (size_t)(m_) * D : xs + (size_t)((m_) - M_P) * D) : X + (size_t)(m_) * D)
#define LN_LOAD(B_, m_) do { const int mq_ = (m_) < M ? (m_) : M - 1; const float* src_ = LN_SRC(mq_); _Pragma("unroll") for (int j = 0; j < 4; ++j) B_[j] = ((const f32x4*)src_)[lane + 64 * j]; } while (0)
    f32x4 bA[4], bB[4];
    LN_LOAD(bA, gw); LN_LOAD(bB, gw + NGW);
    auto process = [&](f32x4 (&buf)[4], int m) {
        f32x4 v[4]; float s = 0.f;
#pragma unroll
        for (int j = 0; j < 4; ++j) { v[j] = buf[j]; s += (v[j].x + v[j].y) + (v[j].z + v[j].w); }
        LN_LOAD(buf, m + 2 * NGW);
        const float mean = wave_sum(s) * (1.f / D); float s2 = 0.f;
#pragma unroll
        for (int j = 0; j < 4; ++j) { v[j] = v[j] - mean; s2 += (v[j].x * v[j].x + v[j].y * v[j].y) + (v[j].z * v[j].z + v[j].w * v[j].w); }
        const float rstd = 1.f / sqrtf(wave_sum(s2) * (1.f / D) + 1e-5f);
        const float* mrow = modl ? modl + (size_t)batch_of_row(m) * 6144 + sh_off : nullptr;
        if (stats && lane == 0) { stats[2 * (size_t)m] = mean; stats[2 * (size_t)m + 1] = rstd; }
#pragma unroll
        for (int j = 0; j < 4; ++j) { const int c4 = lane + 64 * j;
            const f32x4 y = v[j] * rstd * ((const f32x4*)gam)[c4] + ((const f32x4*)bet)[c4];
            if (!stats) ((f32x4*)(X + (size_t)m * D))[c4] = y;
            if (XN) { const f32x4 h = y * (((const f32x4*)(mrow + 1024))[c4] + 1.0f) + ((const f32x4*)mrow)[c4];
                v2u w; w.x = pk2(h.x, h.y); w.y = pk2(h.z, h.w); ((v2u*)(XN + (size_t)m * D))[c4] = w; } }
    };
#pragma unroll 1
    for (int m = gw; m < M; m += 2 * NGW) { process(bA, m); if (m + NGW < M) process(bB, m + NGW); }
#undef LN_LOAD
#undef LN_SRC
}

__device__ __forceinline__ void conv_items(const bf16* P, bf16* mix, const float* cw  , int first, int stride) {
    const int c0 = (first & 31) * 8;
    f32x4 wt[3][2];
#pragma unroll
    for (int k = 0; k < 3; ++k) { wt[k][0] = *(const f32x4*)(cw + k * 256 + c0); wt[k][1] = *(const f32x4*)(cw + k * 256 + c0 + 4); }
#pragma unroll 2
    for (int it = first; it < M * 32; it += stride) {
        const int m = it >> 5;
        const int b = batch_of_row(m); int row0, S; batch_info(b, row0, S); const int t = m - row0;
        const bf16* pr = P + (size_t)m * D_IN + c0;
        const v4u zz = {0u, 0u, 0u, 0u};
        const v4u bg = *(const v4u*)pr;
        const v4u c1 = *(const v4u*)(pr + 256), u1 = *(const v4u*)(pr + 512);
        const v4u cm = t > 0 ? *(const v4u*)(pr - D_IN + 256) : zz, um = t > 0 ? *(const v4u*)(pr - D_IN + 512) : zz;
        const v4u cp = t < S - 1 ? *(const v4u*)(pr + D_IN + 256) : zz, up = t < S - 1 ? *(const v4u*)(pr + D_IN + 512) : zz;
        v4u o;
#pragma unroll
        for (int e = 0; e < 4; ++e) {
            const float w0l = wt[0][e >> 1][(2 * e) & 3], w0h = wt[0][e >> 1][(2 * e + 1) & 3], w1l = wt[1][e >> 1][(2 * e) & 3], w1h = wt[1][e >> 1][(2 * e + 1) & 3], w2l = wt[2][e >> 1][(2 * e) & 3], w2h = wt[2][e >> 1][(2 * e + 1) & 3];
            const float yl = bflo(bg[e]) * (w0l * bflo(cm[e]) * bflo(um[e]) + w1l * bflo(c1[e]) * bflo(u1[e]) + w2l * bflo(cp[e]) * bflo(up[e]));
            const float yh = bfhi(bg[e]) * (w0h * bfhi(cm[e]) * bfhi(um[e]) + w1h * bfhi(c1[e]) * bfhi(u1[e]) + w2h * bfhi(cp[e]) * bfhi(up[e]));
            o[e] = pk2(yl, yh);
        }
        *(v4u*)(mix + (size_t)m * D + c0) = o;
    }
}

__device__ __forceinline__ void attn_unit(const bf16* P, bf16* mix, const float* sinkl, int u, LAS unsigned char* lds, int tid, int wave, int lane) {
    int b, r;
    if (u < 256) { b = u >> 6; r = u & 63; } else { b = 4 + ((u - 256) >> 7); r = (u - 256) & 127; }
    const int qb = r >> 1, hk = r & 1;
    int row0, S; batch_info(b, row0, S);
    const int q0 = qb * 128;
    LAS bf16* Ks = (LAS bf16*)lds;
    LAS bf16* Vt = (LAS bf16*)(lds + 57600);
    const int fr = lane & 15, fq = lane >> 4;
    const int qa = q0 + 16 * wave;
    const size_t qrow = (size_t)(row0 + qa + fr);
    bf16x8 qfn[2];
#pragma unroll
    for (int ks = 0; ks < 2; ++ks) qfn[ks] = *(const bf16x8*)(P + qrow * D_IN + 768 + (hk * 4) * 64 + 32 * ks + 8 * fq);
    {
        v4u kvr[7], vvr[7];
#pragma unroll
        for (int r = 0; r < 7; ++r) { const int idx = tid + NTHREADS * r; const int dg = idx / 400, kk = idx - dg * 400; const int t = q0 - 128 + kk;
            kvr[r] = (v4u){0u, 0u, 0u, 0u}; vvr[r] = (v4u){0u, 0u, 0u, 0u};
            if (idx < 3200 && t >= 0 && t < S) { const bf16* pr = P + (size_t)(row0 + t) * D_IN + 1280 + hk * 64 + dg * 8; kvr[r] = *(const v4u*)pr; vvr[r] = *(const v4u*)(pr + 128); } }
#pragma unroll
        for (int r = 0; r < 7; ++r) { const int idx = tid + NTHREADS * r; const int dg = idx / 400, kk = idx - dg * 400;
            if (idx < 3200) { *(LAS v4u*)(Ks + kk * 72 + dg * 8) = kvr[r];
#pragma unroll
                for (int e = 0; e < 4; ++e) { Vt[(dg * 8 + 2 * e) * 408 + kk] = (bf16)(vvr[r][e] & 0xffffu); Vt[(dg * 8 + 2 * e + 1) * 408 + kk] = (bf16)(vvr[r][e] >> 16); } } }
    }
    __syncthreads();
#pragma unroll 1
    for (int g = 0; g < 4; ++g) {
        const int h = hk * 4 + g;
        int frl = fr; asm volatile("" : "+v"(frl));
        const float LOG2E = 1.4426950408889634f;
        const float nslope = -exp2f(-(float)(h + 1)) * LOG2E, qs = 0.125f * LOG2E; const float sink2 = sinkl[h] * LOG2E;
        const float relb = (float)(4 * fq - 128 - frl);
        const float rlo = fmaxf(-128.f, -(float)(qa + frl)), rhi = fminf(128.f, (float)(S - 1 - qa - frl));
        const float mid = 0.5f * (rlo + rhi), half = 0.5f * (rhi - rlo);
        bf16x8 qf[2];
#pragma unroll
        for (int ks = 0; ks < 2; ++ks) qf[ks] = qfn[ks];
        { const int hn = h < hk * 4 + 3 ? h + 1 : h;
#pragma unroll
          for (int ks = 0; ks < 2; ++ks) qfn[ks] = *(const bf16x8*)(P + qrow * D_IN + 768 + hn * 64 + 32 * ks + 8 * fq); }
        float sc[18][4]; float mx = -INFINITY;
#pragma unroll
        for (int kt = 0; kt < 17; ++kt) {
            f32x4 acc = {0.f, 0.f, 0.f, 0.f};
#pragma unroll
            for (int ks = 0; ks < 2; ++ks) { const bf16x8 kf = *(const LAS bf16x8*)(Ks + (16 * wave + 16 * kt + fr) * 72 + 32 * ks + 8 * fq); acc = MFMA_BF16(kf, qf[ks], acc); }
#pragma unroll
            for (int j = 0; j < 4; ++j) { const float relf = relb + (float)(16 * kt + j);
                const float t = __builtin_fmaf(fabsf(relf), nslope, acc[j] * qs);
                const float s2 = fabsf(relf - mid) <= half ? t : -INFINITY; sc[kt][j] = s2; mx = fmaxf(mx, s2); }
            if (kt & 1) __builtin_amdgcn_sched_barrier(0);
        }
        mx = fmaxf(mx, __shfl_xor(mx, 16)); mx = fmaxf(mx, __shfl_xor(mx, 32));
        const float mm = fmaxf(mx, sink2);
        float sum = 0.f;
#pragma unroll
        for (int kt = 0; kt < 17; ++kt)
#pragma unroll
            for (int j = 0; j < 4; ++j) { const float e = __builtin_amdgcn_exp2f(sc[kt][j] - mm); sc[kt][j] = e; sum += e; }
#pragma unroll
        for (int j = 0; j < 4; ++j) sc[17][j] = 0.f;
        sum += __shfl_xor(sum, 16); sum += __shfl_xor(sum, 32);
        const float inv = 1.f / (sum + __builtin_amdgcn_exp2f(sink2 - mm));
        bf16x8 pb[9];
#pragma unroll
        for (int c = 0; c < 9; ++c) { v4u w; w.x = pk2(sc[2 * c][0], sc[2 * c][1]); w.y = pk2(sc[2 * c][2], sc[2 * c][3]);
            w.z = pk2(sc[2 * c + 1][0], sc[2 * c + 1][1]); w.w = pk2(sc[2 * c + 1][2], sc[2 * c + 1][3]); pb[c] = __builtin_bit_cast(bf16x8, w); }
#pragma unroll 1
        for (int dt = 0; dt < 4; ++dt) {
            f32x4 acc = {0.f, 0.f, 0.f, 0.f};
#pragma unroll
            for (int c = 0; c < 9; ++c) { const LAS bf16* vp = Vt + (16 * dt + fr) * 408 + 16 * wave + 32 * c + 4 * fq;
                const v2u lo = *(const LAS v2u*)vp, hi = *(const LAS v2u*)(vp + 16);
                v4u w; w.x = lo.x; w.y = lo.y; w.z = hi.x; w.w = hi.y; acc = MFMA_BF16(__builtin_bit_cast(bf16x8, w), pb[c], acc); }
            v2u w; w.x = pk2(acc[0] * inv, acc[1] * inv); w.y = pk2(acc[2] * inv, acc[3] * inv);
            *(v2u*)(mix + qrow * D + 256 + h * 64 + 16 * dt + 4 * fq) = w;
        }
    }
    __syncthreads();
}

__device__ __forceinline__ void dn_prep(const Args& a, unsigned char* ws, int l, LAS unsigned char* lds, int tid, int wave, int lane, int bid, int G) {
    const bf16* P = (const bf16*)(ws + WS_P);
    bf16* dnc = (bf16*)(ws + WS_DNC); bf16* qhat = (bf16*)(ws + WS_QH); float* eg = (float*)(ws + WS_EG); float* egl = (float*)(ws + WS_EGL);
    bf16* negw = dnc, *Am = dnc + 4096, *kdT = dnc + 8192, *uT = dnc + 12288;
    LAS float* qh = (LAS float*)lds;
    LAS float* kh = qh + 64 * 65;
    LAS float* vv = kh + 64 * 65;
    LAS float* Ls = (LAS float*)(lds + 49920);
    LAS float* gcs = (LAS float*)(lds + 82688);
    LAS float* bts = gcs + 128;
    LAS float* bws = bts + 128;
    LAS float* cws = bws + 128;
    const int fr = lane & 15, fq = lane >> 4;
#define LBAR() do { asm volatile("s_waitcnt lgkmcnt(0)" ::: "memory"); __builtin_amdgcn_s_barrier(); asm volatile("" ::: "memory"); } while (0)
    const int NU = NCHUNK * 4;
    LAS unsigned char* rawb = lds + 86528;
    unsigned ga = 0, gb = 0;
    auto load_unit = [&](int unit) {
        const int cgi = unit >> 2, h = unit & 3; const int rowc = cgi * 64;
        const int b = batch_of_row(rowc); int row0, S; batch_info(b, row0, S);
        const int t0 = rowc - row0;
#pragma unroll
        for (int r = 0; r < 4; ++r) { const int p = tid + NTHREADS * r;
            if (p < 1584) { const int rr = p / 24, c = p % 24; int t = t0 - 1 + rr; t = t < 0 ? 0 : (t > S - 1 ? S - 1 : t);
                __builtin_amdgcn_global_load_lds((const unsigned*)(P + (size_t)(row0 + t) * D_IN + 1536 + (c >> 3) * 256 + h * 64 + (c & 7) * 8), (LAS unsigned*)(rawb + r * 8192 + wave * 1024), 16, 0, 0); } }
        if (wave < 2) { const int io = wave ? 63 - lane : lane; const bf16* pg = P + (size_t)(rowc + io) * D_IN + 2560 + h; ga = pg[wave * 4]; gb = pg[8 + wave * 4]; }
    };
    int h_loaded = -1;
    if (bid < NU) load_unit(bid);
    asm volatile("s_waitcnt vmcnt(0)" ::: "memory"); LBAR();
    for (int unit = bid; unit < NU; unit += G) {
        const int cgi = unit >> 2, h = unit & 3;
        const int rowc = cgi * 64;
        const size_t cid0 = ((size_t)cgi * 4 + h) * 2;
        int S, t0; { const int b = batch_of_row(rowc); int row0; batch_info(b, row0, S); t0 = rowc - row0; }
        if (h != h_loaded) {
            for (int i = tid; i < 576; i += NTHREADS) { const int k = i / 192, r = i % 192; cws[i] = a.in[11][(size_t)l * 2304 + k * 768 + (r >> 6) * 256 + h * 64 + (r & 63)]; }
            h_loaded = h; LBAR();
        }
        const unsigned gca = ga, gcb = gb;
        { const int i = tid >> 3, dg = tid & 7; const int t = t0 + i;
          const v4u zz = {0u, 0u, 0u, 0u};
#pragma unroll
          for (int wq = 0; wq < 3; ++wq) {
              const LAS unsigned char* rp = rawb + ((i * 24) + wq * 8 + dg) * 16;
              const v4u r0 = t > 0 ? *(const LAS v4u*)rp : zz, r1 = *(const LAS v4u*)(rp + 384), r2 = t < S - 1 ? *(const LAS v4u*)(rp + 768) : zz;
              LAS float* dst = (wq == 0 ? qh : (wq == 1 ? kh : vv)) + i * 65 + dg * 8;
              const LAS float* c0 = cws + wq * 64 + dg * 8;
#pragma unroll
              for (int e = 0; e < 4; ++e) {
                  float yl = c0[2 * e] * bflo(r0[e]) + c0[192 + 2 * e] * bflo(r1[e]) + c0[384 + 2 * e] * bflo(r2[e]);
                  float yh = c0[2 * e + 1] * bfhi(r0[e]) + c0[192 + 2 * e + 1] * bfhi(r1[e]) + c0[384 + 2 * e + 1] * bfhi(r2[e]);
                  dst[2 * e] = yl / (1.f + __expf(-yl)); dst[2 * e + 1] = yh / (1.f + __expf(-yh));
              }
          } }
        LBAR();
        if (unit + G < NU) load_unit(unit + G);
        { const int pair = tid >> 2, sub = tid & 3, which = pair >> 6, i = pair & 63;
          LAS float* rowp = (which ? kh : qh) + i * 65 + sub * 16;
          float vals[16]; float s = 0.f;
#pragma unroll
          for (int e = 0; e < 16; ++e) { vals[e] = rowp[e]; s += vals[e] * vals[e]; }
          s += __shfl_xor(s, 1); s += __shfl_xor(s, 2);
          const float rs = (1.f / sqrtf(s + 1e-6f)) * (which ? 1.f : 0.125f);
#pragma unroll
          for (int e = 0; e < 16; ++e) rowp[e] = vals[e] * rs; }
        if (wave < 2) { const int dir = wave, ip = lane, io = dir ? 63 - ip : ip;
          const float av = bf1((bf16)gca), bv = bf1((bf16)gcb); (void)io;
          const float alog = a.in[12 + dir][l * 4 + h], dtb = a.in[14 + dir][l * 4 + h];
          const float xx = av + dtb; const float sp = xx > 20.f ? xx : __logf(1.f + __expf(xx));
          const float gg = -__expf(alog) * sp; const float beta = 1.f / (1.f + __expf(-bv));
          float c = gg;
#pragma unroll
          for (int off = 1; off < 64; off <<= 1) { const float tt = __shfl_up(c, off); if (lane >= off) c += tt; }
          gcs[dir * 64 + ip] = c; bts[dir * 64 + ip] = beta; bws[dir * 64 + ip] = beta * __expf(c); }
        LBAR();
        { const int which = wave >> 2, ti = wave & 3;
          const LAS float* Arow = (which ? qh : kh) + (16 * ti + fr) * 65;
          f32x4 acc[4];
#pragma unroll
          for (int tj = 0; tj < 4; ++tj) acc[tj] = (f32x4){0.f, 0.f, 0.f, 0.f};
#pragma unroll
          for (int kk = 0; kk < 16; ++kk) { const float av = Arow[4 * kk + fq];
#pragma unroll
              for (int tj = 0; tj < 4; ++tj) { const float bv = kh[(16 * tj + fr) * 65 + 4 * kk + fq]; acc[tj] = __builtin_amdgcn_mfma_f32_16x16x4f32(av, bv, acc[tj], 0, 0, 0); } }
#pragma unroll
          for (int tj = 0; tj < 4; ++tj)
#pragma unroll
              for (int j = 0; j < 4; ++j) { const int i = 16 * ti + 4 * fq + j, jc = 16 * tj + fr, i1 = 63 - i, j1 = 63 - jc; const float val = acc[tj][j];
                  if (which == 0) {
                      const float d0 = jc < i ? gcs[i] - gcs[jc] : 0.f, d1 = j1 < i1 ? gcs[64 + i1] - gcs[64 + j1] : 0.f;
                      Ls[i * 64 + jc] = jc < i ? bts[i] * val * __expf(d0) : 0.f;
                      Ls[4096 + i1 * 64 + j1] = j1 < i1 ? bts[64 + i1] * val * __expf(d1) : 0.f;
                  } else {
                      const float d0 = jc <= i ? gcs[i] - gcs[jc] : 0.f, d1 = j1 <= i1 ? gcs[64 + i1] - gcs[64 + j1] : 0.f;
                      Am[cid0 * 16384 + i * 64 + (jc & 32) + ppos(jc & 31)] = f2bf(jc <= i ? val * __expf(d0) : 0.f);
                      Am[(cid0 + 1) * 16384 + i1 * 64 + (j1 & 32) + ppos(j1 & 31)] = f2bf(j1 <= i1 ? val * __expf(d1) : 0.f);
                  } } }
        asm volatile("s_waitcnt vmcnt(0)" ::: "memory");
        LBAR();
        int tid4 = tid; asm volatile("" : "+v"(tid4));
        if (wave < 4) {
            const int dir = wave >> 1, col = tid4 & 127; const bool isW = (wave & 1) != 0;
            int st = dir ? -65 : 65; asm volatile("" : "+v"(st));
            const LAS float* sp = (isW ? kh + (col - 64) : vv + col) + (dir ? 63 * 65 : 0);
            const LAS float* scl = (isW ? bws : bts) + dir * 64;
            const LAS float* Lr = Ls + dir * 4096;
            const size_t cid = cid0 + dir;
            float x[64];
#pragma unroll
            for (int i = 0; i < 64; ++i) x[i] = 0.f;
#pragma unroll
            for (int i = 0; i < 64; ++i) {
                f32x4 lb[16];
                float acc = scl[i] * *sp; sp += st;
#pragma unroll
                for (int j4 = 0; j4 < (i + 3) / 4; ++j4) lb[j4] = *(const LAS f32x4*)(Lr + i * 64 + 4 * j4);
                __builtin_amdgcn_sched_barrier(0);
#pragma unroll
                for (int j4 = 0; j4 < (i + 3) / 4; ++j4) { const f32x4 l4 = lb[j4];
                    acc -= l4.x * x[4 * j4]; acc -= l4.y * x[4 * j4 + 1]; acc -= l4.z * x[4 * j4 + 2]; acc -= l4.w * x[4 * j4 + 3]; }
                x[i] = acc;
                __builtin_amdgcn_sched_barrier(0);
            }
            if (!isW) {
                bf16* dst = uT + cid * 16384 + col * 64;
#pragma unroll
                for (int q = 0; q < 8; ++q) { v4u w; w.x = pk2(x[8 * q], x[8 * q + 1]); w.y = pk2(x[8 * q + 2], x[8 * q + 3]); w.z = pk2(x[8 * q + 4], x[8 * q + 5]); w.w = pk2(x[8 * q + 6], x[8 * q + 7]); *(v4u*)(dst + 8 * q) = w; }
            } else {
                const int dk = col - 64; bf16* dst = negw + cid * 16384 + (dk & 32) + ppos(dk & 31);
#pragma unroll
                for (int i = 0; i < 64; ++i) dst[i * 64] = f2bf(-x[i]);
            }
        } else {
            const int t2 = tid4 - 256; const int lane4 = tid4 & 63;
            { const int i = t2 >> 2, part = t2 & 3, g32 = (part >> 1) * 32, pb = (part & 1) * 16;
              const LAS float* qr = qh + i * 65 + g32;
              v4u w0, w1;
#pragma unroll
              for (int e = 0; e < 4; ++e) { w0[e] = pk2(qr[dmap(pb + 2 * e)], qr[dmap(pb + 2 * e + 1)]); w1[e] = pk2(qr[dmap(pb + 8 + 2 * e)], qr[dmap(pb + 8 + 2 * e + 1)]); }
              bf16* dst = qhat + (size_t)(rowc + i) * 256 + h * 64 + 16 * part; *(v4u*)dst = w0; *(v4u*)(dst + 8) = w1; }
            const int dir = (wave - 4) >> 1; const size_t cid = cid0 + dir;
            if (((wave - 4) & 1) == 0) {
                const int dk = lane4; const float gl = gcs[dir * 64 + 63];
                int st = dir ? -65 : 65; asm volatile("" : "+v"(st));
                const LAS float* kb = kh + dk + (dir ? 63 * 65 : 0);
                bf16* dst = kdT + cid * 16384 + dk * 64;
#pragma unroll
                for (int q = 0; q < 8; ++q) { float vals[8];
#pragma unroll
                    for (int e = 0; e < 8; ++e) { const int pos = 8 * q + e; const int ip = (pos & 32) + dmap(pos & 31); vals[e] = kb[ip * st] * __expf(gl - gcs[dir * 64 + ip]); }
                    v4u w; w.x = pk2(vals[0], vals[1]); w.y = pk2(vals[2], vals[3]); w.z = pk2(vals[4], vals[5]); w.w = pk2(vals[6], vals[7]); *(v4u*)(dst + 8 * q) = w; }
            } else {
                const float e = __expf(gcs[dir * 64 + lane4]); eg[cid * 64 + lane4] = e; if (lane4 == 63) egl[cid] = e;
            }
        }
        LBAR();
    }
}

__device__ __forceinline__ void dn_scan_block(unsigned char* ws, int ch, LAS unsigned char* lds, int wave, int lane) {
    bf16* P = (bf16*)(ws + WS_P);
    const bf16* uT = (const bf16*)(ws + WS_DNC) + 12288; const float* eg = (const float*)(ws + WS_EG); const float* egl = (const float*)(ws + WS_EGL);
    int b, h, dir;
    if (ch < 64) { b = 4 + (ch >> 3); h = (ch >> 1) & 3; dir = ch & 1; } else { const int c2 = ch - 64; b = c2 >> 3; h = (c2 >> 1) & 3; dir = c2 & 1; }
    int row0, S; batch_info(b, row0, S);
    const int N = S >> 6, chunk0 = row0 >> 6;
    const int fr = lane & 15, fq = lane >> 4;
#define SCAN_CID(n_) (((size_t)(chunk0 + (dir ? N - 1 - (n_) : (n_))) * 4 + h) * 2 + dir)
    auto flush_o = [&](int n, int lw) {
        const size_t cid = SCAN_CID(n); const int rowc = (int)(cid >> 3) * 64;
        const LAS unsigned char* ob = lds + 131072 + (n & 1) * 8192;
#pragma unroll
        for (int r = 0; r < 2; ++r) { const int tl = lw * 16 + r * 8 + (lane >> 3), c8 = (lane & 7) * 8;
            const v4u w = *(const LAS v4u*)(ob + tl * 128 + c8 * 2);
            *(v4u*)(P + (size_t)(rowc + (dir ? 63 - tl : tl)) * D_IN + 1536 + dir * 256 + h * 64 + c8) = w; }
    };
    if (wave >= 4) {
        const int lw = wave - 4;
        const unsigned char* abase = ws + WS_DNC + (lw == 0 ? 0 : (lw == 2 ? 8192 : 16384));
        const unsigned lane_off = (unsigned)(fr * 128 + fq * 16);
        auto issue = [&](int n) {
            const int nn = n < N ? n : N - 1;
            const size_t cid = SCAN_CID(nn);
            LAS unsigned char* dst = lds + (nn & 3) * 32768 + lw * 8192;
            if (lw != 1) {
                const unsigned char* src = abase + cid * 32768 + lane_off;
#pragma unroll
                for (int m = 0; m < 4; ++m)
#pragma unroll
                    for (int ks = 0; ks < 2; ++ks)
                        __builtin_amdgcn_global_load_lds((const unsigned*)(src + m * 2048 + ks * 64), (LAS unsigned*)(dst + (m * 2 + ks) * 1024), 16, 0, 0);
            } else {
                const int rowc = (int)(cid >> 3) * 64;
#pragma unroll
                for (int m = 0; m < 4; ++m) { const int tl = 16 * m + fr; const unsigned char* src = ws + WS_QH + (size_t)(rowc + (dir ? 63 - tl : tl)) * 512 + h * 128 + fq * 16;
#pragma unroll
                    for (int ks = 0; ks < 2; ++ks)
                        __builtin_amdgcn_global_load_lds((const unsigned*)(src + ks * 64), (LAS unsigned*)(dst + (m * 2 + ks) * 1024), 16, 0, 0); }
            }
        };
        issue(0); issue(1); issue(2);
        asm volatile("s_waitcnt vmcnt(16)" ::: "memory"); __builtin_amdgcn_s_barrier(); asm volatile("" ::: "memory");
        for (int n = 0; n < N; ++n) {
            issue(n + 3);
            asm volatile("s_waitcnt vmcnt(16)" ::: "memory"); __builtin_amdgcn_s_barrier(); asm volatile("" ::: "memory");
        }
        asm volatile("s_waitcnt vmcnt(0)" ::: "memory");
    } else {
        const int e0 = 16 * wave;
        f32x4 St[4];
#pragma unroll
        for (int dt = 0; dt < 4; ++dt) St[dt] = (f32x4){0.f, 0.f, 0.f, 0.f};
        int vz = 0; asm volatile("" : "+v"(vz));
        struct Priv { v2u ur[4]; f32x4 eg[4]; float el; };
        Priv b0, b1, b2, b3;
#define SCAN_LDP(n_, B_) do { const int nq_ = (n_) < N ? (n_) : N - 1; const size_t cq_ = SCAN_CID(nq_); \
        _Pragma("unroll") for (int m = 0; m < 4; ++m) { B_.ur[m] = *(const v2u*)(uT + cq_ * 16384 + (e0 + fr) * 64 + 16 * m + 4 * fq); B_.eg[m] = *(const f32x4*)(eg + cq_ * 64 + 16 * m + 4 * fq); } \
        B_.el = egl[cq_ + vz]; } while (0)
        SCAN_LDP(0, b0); SCAN_LDP(1, b1); SCAN_LDP(2, b2);
#define SCAN_PIN(B_) do { _Pragma("unroll") for (int m = 0; m < 4; ++m) asm volatile("" : "+v"(B_.ur[m]), "+v"(B_.eg[m])); asm volatile("" : "+v"(B_.el)); } while (0)
        SCAN_PIN(b0); SCAN_PIN(b1); SCAN_PIN(b2);
        asm volatile("" ::: "memory"); __builtin_amdgcn_s_barrier(); asm volatile("" ::: "memory");
        auto body = [&](int n, const Priv& cur, Priv& nxt) {
            if (n > 0) flush_o(n - 1, wave);
            SCAN_LDP(n + 3, nxt);
            const LAS unsigned char* st = lds + (n & 3) * 32768 + lane * 16;
#define FRAG(arr, m, ks) (*(const LAS bf16x8*)(st + (arr) * 8192 + ((m) * 2 + (ks)) * 1024))
            bf16x8 Sb[2], Vb[2];
            bf16x8 fa[4][2], fb[4][2];
#pragma unroll
            for (int m = 0; m < 4; ++m)
#pragma unroll
                for (int ks = 0; ks < 2; ++ks) { fa[m][ks] = FRAG(0, m, ks); fb[m][ks] = FRAG(1, m, ks); }
#pragma unroll
            for (int ks = 0; ks < 2; ++ks) { v4u w; w.x = pk2(St[2 * ks][0], St[2 * ks][1]); w.y = pk2(St[2 * ks][2], St[2 * ks][3]); w.z = pk2(St[2 * ks + 1][0], St[2 * ks + 1][1]); w.w = pk2(St[2 * ks + 1][2], St[2 * ks + 1][3]); Sb[ks] = __builtin_bit_cast(bf16x8, w); }
            __builtin_amdgcn_sched_barrier(0);
            f32x4 vn[4], oo[4];
#pragma unroll
            for (int m = 0; m < 4; ++m) {
                f32x4 acc = {bflo(cur.ur[m].x), bfhi(cur.ur[m].x), bflo(cur.ur[m].y), bfhi(cur.ur[m].y)};
                acc = MFMA_BF16(fa[m][0], Sb[0], acc); acc = MFMA_BF16(fa[m][1], Sb[1], acc); vn[m] = acc;
                f32x4 o = {0.f, 0.f, 0.f, 0.f};
                o = MFMA_BF16(fb[m][0], Sb[0], o); o = MFMA_BF16(fb[m][1], Sb[1], o); oo[m] = o * cur.eg[m];
            }
#pragma unroll
            for (int m = 0; m < 4; ++m)
#pragma unroll
                for (int ks = 0; ks < 2; ++ks) { fa[m][ks] = FRAG(3, m, ks); fb[m][ks] = FRAG(2, m, ks); }
            __builtin_amdgcn_sched_barrier(0);
#pragma unroll
            for (int ks = 0; ks < 2; ++ks) { v4u w; w.x = pk2(vn[2 * ks][0], vn[2 * ks][1]); w.y = pk2(vn[2 * ks][2], vn[2 * ks][3]); w.z = pk2(vn[2 * ks + 1][0], vn[2 * ks + 1][1]); w.w = pk2(vn[2 * ks + 1][2], vn[2 * ks + 1][3]); Vb[ks] = __builtin_bit_cast(bf16x8, w); }
#pragma unroll
            for (int dt = 0; dt < 4; ++dt) { f32x4 s2 = St[dt] * cur.el; s2 = MFMA_BF16(fa[dt][0], Vb[0], s2); s2 = MFMA_BF16(fa[dt][1], Vb[1], s2); St[dt] = s2; }
            LAS bf16* ob = (LAS bf16*)(lds + 131072 + (n & 1) * 8192) + e0 + fr;
#pragma unroll
            for (int m = 0; m < 4; ++m) {
                f32x4 o = oo[m]; o = MFMA_BF16(fb[m][0], Vb[0], o); o = MFMA_BF16(fb[m][1], Vb[1], o);
#pragma unroll
                for (int j = 0; j < 4; ++j) ob[(16 * m + 4 * fq + j) * 64] = f2bf(o[j]);
            }
#undef FRAG
            asm volatile("s_waitcnt lgkmcnt(0)" ::: "memory"); __builtin_amdgcn_s_barrier(); asm volatile("" ::: "memory");
        };
#pragma unroll 1
        for (int n = 0; n < N; n += 4) { body(n, b0, b3); body(n + 1, b1, b0); body(n + 2, b2, b1); body(n + 3, b3, b2); }
        flush_o(N - 1, wave);
    }
#undef SCAN_LDP
#undef SCAN_PIN
#undef SCAN_CID
}

__device__ __forceinline__ void dn_post(const bf16* P, bf16* mix, const float* ng  , int gw, int NGW, int lane) {
    const int half = lane >> 5, c = (lane & 31) * 8;
    const f32x4 g0 = *(const f32x4*)(ng + (c & 63)), g1 = *(const f32x4*)(ng + (c & 63) + 4);
    v4u ofn = {0u, 0u, 0u, 0u}, obn = ofn, zzn = ofn;
    if (gw < M / 2) { const bf16* pr = P + (size_t)(2 * gw + half) * D_IN; ofn = *(const v4u*)(pr + 1536 + c); obn = *(const v4u*)(pr + 1792 + c); zzn = *(const v4u*)(pr + 2304 + c); }
#pragma unroll 1
    for (int pk = gw; pk < M / 2; pk += NGW) {
        const v4u of = ofn, ob = obn, zz = zzn;
        { const int pn = pk + NGW < M / 2 ? pk + NGW : pk; const bf16* pr = P + (size_t)(2 * pn + half) * D_IN; ofn = *(const v4u*)(pr + 1536 + c); obn = *(const v4u*)(pr + 1792 + c); zzn = *(const v4u*)(pr + 2304 + c); }
        float o[8], z[8]; float ss = 0.f;
#pragma unroll
        for (int e = 0; e < 4; ++e) { o[2 * e] = bflo(of[e]) + bflo(ob[e]); o[2 * e + 1] = bfhi(of[e]) + bfhi(ob[e]); z[2 * e] = bflo(zz[e]); z[2 * e + 1] = bfhi(zz[e]);
            ss += o[2 * e] * o[2 * e] + o[2 * e + 1] * o[2 * e + 1]; }
        ss += __shfl_xor(ss, 1); ss += __shfl_xor(ss, 2); ss += __shfl_xor(ss, 4);
        const float r = 1.f / sqrtf(ss * (1.f / 64.f) + 1e-6f);
        v4u w;
#pragma unroll
        for (int e = 0; e < 4; ++e) { const float ga = e < 2 ? g0[2 * e] : g1[2 * e - 4], gb = e < 2 ? g0[2 * e + 1] : g1[2 * e - 3];
            const float ya = o[2 * e] * r * ga * (z[2 * e] / (1.f + __expf(-z[2 * e]))), yb = o[2 * e + 1] * r * gb * (z[2 * e + 1] / (1.f + __expf(-z[2 * e + 1])));
            w[e] = pk2(ya, yb); }
        *(v4u*)(mix + (size_t)(2 * pk + half) * D + 768 + c) = w;
    }
}

#ifndef MK_DEBUG
#define MK_DEBUG 0
#endif
#if MK_DEBUG
constexpr size_t WS_FLAG = WS_END;
__device__ __forceinline__ bool bad16(unsigned u) { return (u & 0x7f80u) >= (147u << 7); }
__device__ __forceinline__ bool bad32(unsigned u) { return (u & 0x7f800000u) >= (147u << 23); }
__global__ void __launch_bounds__(512) dbg_scan(const unsigned* buf, size_t nwords, int is16, unsigned* flag, int code) {
    bool bad = false;
    for (size_t i = (size_t)blockIdx.x * 512 + threadIdx.x; i < nwords; i += (size_t)gridDim.x * 512) { const unsigned u = buf[i]; bad |= is16 ? (bad16(u) || bad16(u >> 16)) : bad32(u); }
    if (bad) atomicMin(flag, (unsigned)code);
}
__global__ void __launch_bounds__(512) dbg_scan2(const unsigned short* buf, int rows, int ld, int c0, int nc, unsigned* flag, int code) {
    bool bad = false;
    for (size_t i = (size_t)blockIdx.x * 512 + threadIdx.x; i < (size_t)rows * nc; i += (size_t)gridDim.x * 512) { const size_t r = i / nc; const int c = (int)(i % nc); bad |= bad16(buf[r * ld + c0 + c]); }
    if (bad) atomicMin(flag, (unsigned)code);
}
__global__ void __launch_bounds__(512) dbg_fin(float* out, size_t n, const unsigned* flag) {
    const unsigned f = *flag; if (f == 0x7f7f7f7fu) return;
    const float v = sqrtf((float)(f + 1));
    for (size_t i = (size_t)blockIdx.x * 512 + threadIdx.x; i < n; i += (size_t)gridDim.x * 512) out[i] = v;
}
#endif
constexpr size_t WS_BAR = 1966080;
#define RLX_AGENT __ATOMIC_RELAXED, __HIP_MEMORY_SCOPE_AGENT
#define XB_TMO      128
#define XB_XCNT(j)  (256  + 64 * (j))
#define XB_XSUB(j)  (1280 + 64 * (j))
#define XB_XGEN(j)  (2304 + 64 * (j))
#define XB_TOP      3328
#define XB_TOPGEN   3392
#define XCD_BAR_WORDS 3456
#define XB_SPIN_CAP (1u << 18)

__device__ __forceinline__ unsigned xb_ld(unsigned* p)              { return __hip_atomic_load(p, __ATOMIC_RELAXED, __HIP_MEMORY_SCOPE_AGENT); }
__device__ __forceinline__ unsigned xb_add(unsigned* p, unsigned v) { return __hip_atomic_fetch_add(p, v, __ATOMIC_RELAXED, __HIP_MEMORY_SCOPE_AGENT); }
__device__ __forceinline__ unsigned xb_xcc_id() { return (unsigned)__builtin_amdgcn_s_getreg((3 << 11) | 20) & 0xFu; }
#define XB_SPIN(cond, bar) do { unsigned _sp = 0; while (cond) { __builtin_amdgcn_s_sleep(1); \
    if ((++_sp & 255u) == 0u) { if (xb_ld(&(bar)[XB_TMO])) break; if (_sp > XB_SPIN_CAP) { atomicAdd(&(bar)[XB_TMO], 1u); break; } } } } while (0)

struct XcdBarrier {
    unsigned* bar; unsigned x;
    volatile LAS unsigned* st;
};

__device__ __forceinline__ XcdBarrier xcd_barrier_post(unsigned* bar, volatile LAS unsigned* st) {
    XcdBarrier b; b.bar = bar; b.x = xb_xcc_id(); b.st = st;
    if (threadIdx.x == 0) (void)xb_add(&bar[XB_XCNT(b.x)], 1u);
    return b;
}
__device__ __forceinline__ void xcd_barrier_complete(unsigned* bar, unsigned x, unsigned& nloc, unsigned& nx) {
    const unsigned G = gridDim.x * gridDim.y * gridDim.z;
    unsigned sum, cnt, mine, sp = 0u;
    for (;;) {
        sum = 0u; cnt = 0u; mine = 0u;
#pragma unroll
        for (unsigned j = 0; j < 16; ++j) { const unsigned c = xb_ld(&bar[XB_XCNT(j)]); sum += c; cnt += (c > 0u) ? 1u : 0u; mine = (j == x) ? c : mine; }
        if (sum == G) break;
        __builtin_amdgcn_s_sleep(1);
        if ((++sp & 255u) == 0u) { if (xb_ld(&bar[XB_TMO])) break; if (sp > XB_SPIN_CAP) { atomicAdd(&bar[XB_TMO], 1u); break; } }
    }
    nloc = mine > 0u ? mine : 1u; nx = cnt > 0u ? cnt : 1u;
}

__device__ __forceinline__ void xcd_barrier(const XcdBarrier& b) {
    asm volatile("s_waitcnt vmcnt(0)" ::: "memory");
    __syncthreads();
    if (threadIdx.x == 0) {
        unsigned* bar = b.bar;
        __builtin_amdgcn_s_waitcnt(0);
        unsigned nloc = b.st[0], nx = b.st[1];
        if (nloc == 0u) { xcd_barrier_complete(bar, b.x, nloc, nx); b.st[0] = nloc; b.st[1] = nx; }
        const unsigned old = xb_add(&bar[XB_XSUB(b.x)], 1u);
        const unsigned gen = old / nloc;
        if (old + 1u == (gen + 1u) * nloc) {
            __builtin_amdgcn_fence(__ATOMIC_RELEASE, "agent");
            asm volatile("s_waitcnt vmcnt(0)" ::: "memory");
            const unsigned og = xb_add(&bar[XB_TOP], 1u);
            const unsigned tg = og / nx;
            if (og + 1u == (tg + 1u) * nx) xb_add(&bar[XB_TOPGEN], 1u);
            else XB_SPIN(xb_ld(&bar[XB_TOPGEN]) == tg, bar);
            __builtin_amdgcn_fence(__ATOMIC_ACQUIRE, "agent");
            xb_add(&bar[XB_XGEN(b.x)], 1u);
            asm volatile("s_waitcnt vmcnt(0)" ::: "memory");
        } else {
            XB_SPIN(xb_ld(&bar[XB_XGEN(b.x)]) == gen, bar);
            __builtin_amdgcn_fence(__ATOMIC_ACQUIRE, "agent");
            asm volatile("s_waitcnt vmcnt(0)" ::: "memory");
        }
    }
    __syncthreads();
}

__global__ void __launch_bounds__(NTHREADS, 2) mega(Args a) {
    extern __shared__ __attribute__((aligned(16))) unsigned char lds_raw[];
#ifndef MK_TQOFF
#define MK_TQOFF 0.5f
#endif
#ifndef MK_TIMEPH
#define MK_TIMEPH -1
#endif
#if MK_TIMEPH >= 0
    unsigned long long tacc = 0, tprev = __builtin_amdgcn_s_memrealtime();
#endif
    volatile LAS unsigned* xst = (volatile LAS unsigned*)((LAS unsigned char*)lds_raw + 147456);
    if (threadIdx.x < 2) xst[threadIdx.x] = 0u;
    __syncthreads();
    XcdBarrier xbar = xcd_barrier_post((unsigned*)(a.ws + WS_BAR), xst);
    for (int p = a.ph_lo; p < a.ph_hi; ++p) {
        int tid = threadIdx.x; asm volatile("" : "+v"(tid));
        int bid = blockIdx.x; asm volatile("" : "+s"(bid));
        int G = gridDim.x; asm volatile("" : "+s"(G));
        size_t zoff = 0; asm volatile("" : "+s"(zoff));
        unsigned char* ws = a.ws + zoff;
        float* X = a.out + zoff;
        unsigned ldsoff = 0; asm volatile("" : "+s"(ldsoff));
        LAS unsigned char* lds = (LAS unsigned char*)lds_raw + ldsoff;
        const int lane = tid & 63, wave = __builtin_amdgcn_readfirstlane(tid >> 6);
        const int gw = bid * 8 + wave, NGW = G * 8;
        bf16* XN = (bf16*)(ws + WS_XN); bf16* P = (bf16*)(ws + WS_P); bf16* H = (bf16*)(ws + WS_H);
        const float* modbuf = (const float*)(ws + WS_MOD); float* stats = (float*)(ws + WS_STATS);
        int l = 0, pp = p;
        if (p >= 2) { l = (p - 2) / 9; pp = 2 + (p - 2) % 9; }
        const float* modl = modbuf + (size_t)l * NBATCH * 6144;
#ifndef PHMASK
#define PHMASK 0xFFFF
#endif
#define PH_ON(k) (((PHMASK) >> (k)) & 1)
        switch (pp) {
        case 0: if (!PH_ON(0)) break; for (int cl = 0; cl < DEPTH; ++cl) convert_layer(a, ws, cl, lds, gw, NGW, wave, lane); __syncthreads(); mod_phase(a, ws, lds, tid, wave, lane, bid, G); break;
        case 1: if (!PH_ON(1)) break; ln_rows(a.in[0], a.in[1], true, X, a.in[4], a.in[5], modbuf, 0, XN, stats, gw, NGW, lane); break;
        case 2: if (!PH_ON(2)) break; { pg8::Gemm g{XN, (const bf16*)(ws + WS_WIN + wbase(l)), M, D_INP, D}; pg8::StaticOrder S; S.init(M, D_INP, G, bid); pg8::EpiP E{P};
                  pg8::gemm_phase<pg8::EpiP, pg8::StaticOrder, true, true>(lds, g, S, E, tid); } break;
        case 3: if (!PH_ON(3)) break; dn_prep(a, ws, l, lds, tid, wave, lane, bid, G); break;
        case 4: if (!PH_ON(4)) break; if (bid < NSCAN) { if (PH_ON(11)) dn_scan_block(ws, bid, lds, wave, lane); }
                else if (PH_ON(12)) { const int na = G - NSCAN, ab = bid - NSCAN;
                    const int vb = ((na & 7) == 0 && (NSCAN & 7) == 0) ? (ab & 7) * (na >> 3) + (ab >> 3) : ab;
#pragma unroll 1
                    for (int u = vb; u < 1280; u += na) attn_unit(P, XN, a.in[10] + l * 8, u, lds, tid, wave, lane);
                    conv_items(P, XN, a.in[9] + (size_t)l * 768, ab * NTHREADS + tid, na * NTHREADS); }
                break;
        case 5: if (!PH_ON(5)) break; dn_post(P, XN, a.in[16] + l * 64, gw, NGW, lane); break;
        case 6: if (!PH_ON(6)) break; { pg8::Gemm g{XN, (const bf16*)(ws + WS_WOUT + wbase(l)), M, D, D}; pg8::StaticOrder S; S.init(M, D, G, bid); pg8::EpiRes E{X, modl + 2048, nullptr, stats, l > 0 ? a.in[24] + (l - 1) * D : a.in[4], l > 0 ? a.in[25] + (l - 1) * D : a.in[5], l > 0 ? nullptr : a.in[0], l > 0 ? nullptr : a.in[1]};
                  pg8::gemm_phase<pg8::EpiRes, pg8::StaticOrder, false, true>(lds, g, S, E, tid); } break;
        case 7: if (!PH_ON(7)) break; ln_rows(nullptr, nullptr, false, X, a.in[18] + l * D, a.in[19] + l * D, modl, 3072, XN, stats, gw, NGW, lane); break;
        case 8: if (!PH_ON(8)) break; { pg8::Gemm g{XN, (const bf16*)(ws + WS_W1 + wbase(l)), M, D_FF, D}; pg8::StaticOrder S; S.init(M, D_FF, G, bid); pg8::EpiH E{H, a.in[21] + (size_t)l * D_FF};
                  pg8::gemm_phase<pg8::EpiH, pg8::StaticOrder, true, true>(lds, g, S, E, tid); } break;
        case 9: if (!PH_ON(9)) break; { pg8::Gemm g{H, (const bf16*)(ws + WS_W2 + wbase(l)), M, D, D_FF}; pg8::StaticOrder S; S.init(M, D, G, bid); pg8::EpiRes E{X, modl + 5120, a.in[23] + (size_t)l * D, stats, a.in[18] + l * D, a.in[19] + l * D, nullptr, nullptr};
                  pg8::gemm_phase<pg8::EpiRes, pg8::StaticOrder, false, true>(lds, g, S, E, tid); } break;
        case 10: if (!PH_ON(10)) break; if (l < DEPTH - 1) { ln_rows(nullptr, nullptr, false, X, a.in[24] + l * D, a.in[25] + l * D, modl + (size_t)NBATCH * 6144, 0, XN, stats, gw, NGW, lane); }
                 else ln_rows(nullptr, nullptr, false, X, a.in[24] + l * D, a.in[25] + l * D, nullptr, 0, nullptr, nullptr, gw, NGW, lane);
                 break;
        }
#if MK_TIMEPH >= 0
        { const unsigned long long t0 = __builtin_amdgcn_s_memrealtime();
          cg::this_grid().sync();
          const unsigned long long t1 = __builtin_amdgcn_s_memrealtime();
          if (MK_TIMEPH == 100 || pp == MK_TIMEPH) tacc += t1 - tprev; else if (MK_TIMEPH == 200 + pp) tacc += t1 - t0;
          tprev = t1; }
#else
        if (p + 1 < a.ph_hi) { if (p == a.ph_lo) cg::this_grid().sync(); else xcd_barrier(xbar); }
#endif
    }
#if MK_TIMEPH >= 0
    { unsigned* tw = (unsigned*)(a.ws + WS_END);
      if (blockIdx.x == 0 && threadIdx.x == 0) __hip_atomic_store(tw, (unsigned)(tacc / 100), __ATOMIC_RELAXED, __HIP_MEMORY_SCOPE_AGENT);
      cg::this_grid().sync();
      const float tq = floorf(__logf(fmaxf((float)__hip_atomic_load(tw, __ATOMIC_RELAXED, __HIP_MEMORY_SCOPE_AGENT), 1.f)) * (1.f / 0.4054651f) + MK_TQOFF); const float v = sqrtf(__expf((tq - MK_TQOFF + 0.5f) * 0.4054651f));
      for (size_t i = (size_t)blockIdx.x * NTHREADS + threadIdx.x; i < (size_t)M * D; i += (size_t)gridDim.x * NTHREADS) a.out[i] = v; }
#endif
}
constexpr int NPHASES = 2 + 9 * DEPTH;

extern "C" void kernel_launch(void* const* d_in, const int* in_sizes, int n_in, void* d_out, int out_size, void* d_ws, size_t ws_size, hipStream_t stream) {
    static int grid = 0;
    if (grid == 0) {
        if (n_in != 26 || out_size != M * D || ws_size < 1024 * MiB) { fprintf(stderr, "kernel_launch: unexpected sizes n_in %d out %d ws %zu\n", n_in, out_size, ws_size); grid = -1; return; }
        int dev = 0, cus = 0, per_cu = 0;
        hipGetDevice(&dev); hipDeviceGetAttribute(&cus, hipDeviceAttributeMultiprocessorCount, dev);
        if (hipFuncSetAttribute((const void*)mega, hipFuncAttributeMaxDynamicSharedMemorySize, LDS_BYTES) != hipSuccess) { fprintf(stderr, "kernel_launch: hipFuncSetAttribute failed\n"); grid = -1; return; }
        if (hipOccupancyMaxActiveBlocksPerMultiprocessor(&per_cu, (const void*)mega, NTHREADS, LDS_BYTES) != hipSuccess || per_cu < 1) { fprintf(stderr, "kernel_launch: occupancy query says %d\n", per_cu); per_cu = 1; }
        (void)hipGetLastError();
        grid = cus * 1;
        if (grid <= NSCAN + 8) { fprintf(stderr, "kernel_launch: grid %d too small\n", grid); grid = -1; return; }
    }
    if (grid < 0) return;
    Args a{};
    for (int i = 0; i < 26; ++i) a.in[i] = (const float*)d_in[i];
    a.out = (float*)d_out; a.ws = (unsigned char*)d_ws;
#if MK_MULTI
#if MK_DEBUG
    unsigned* flag = (unsigned*)((unsigned char*)d_ws + WS_FLAG);
    (void)hipMemsetAsync(flag, 0x7f, 4, stream);
    unsigned char* wsb = (unsigned char*)d_ws;
#define DSCAN(off, bytes, is16, code) hipLaunchKernelGGL(dbg_scan, dim3(1024), dim3(512), 0, stream, (const unsigned*)(wsb + (off)), (size_t)(bytes) / 4, is16, flag, code)
#define DSCANX(code) hipLaunchKernelGGL(dbg_scan, dim3(1024), dim3(512), 0, stream, (const unsigned*)d_out, (size_t)M * D, 0, flag, code)
#endif
    for (int p = 0; p < NPHASES; ++p) { a.ph_lo = p; a.ph_hi = p + 1; hipLaunchKernelGGL(mega, dim3(grid), dim3(NTHREADS), LDS_BYTES, stream, a);
#if MK_DEBUG
        const int pp = p < 2 ? p : 2 + (p - 2) % 9;
        const int code = p * 4;
        switch (pp) {
        case 0: DSCAN(WS_MOD, DEPTH * NBATCH * 6144 * 4, 0, code); DSCAN(WS_WIN, WS_P - WS_WIN - MiB / 2, 1, code + 1); break;
        case 1: case 7: case 10: DSCANX(code); DSCAN(WS_XN, (size_t)M * D * 2, 1, code + 1); break;
        case 2: DSCAN(WS_P, (size_t)M * D_IN * 2, 1, code); break;
        case 3: DSCAN(WS_DNC, 320 * MiB, 1, code); DSCAN(WS_QH, 40 * MiB, 1, code + 3); break;
        case 4: hipLaunchKernelGGL(dbg_scan2, dim3(1024), dim3(512), 0, stream, (const unsigned short*)(wsb + WS_XN), M, D, 0, 256, flag, code);
                hipLaunchKernelGGL(dbg_scan2, dim3(1024), dim3(512), 0, stream, (const unsigned short*)(wsb + WS_XN), M, D, 256, 512, flag, code + 1);
                hipLaunchKernelGGL(dbg_scan2, dim3(1024), dim3(512), 0, stream, (const unsigned short*)(wsb + WS_P), M, D_IN, 1536, 512, flag, code + 2);
                hipLaunchKernelGGL(dbg_scan2, dim3(1024), dim3(512), 0, stream, (const unsigned short*)(wsb + WS_XN), M, D, 768, 256, flag, code + 3); break;
        case 5: DSCAN(WS_XN, (size_t)M * D * 2, 1, code); break;
        case 6: case 9: DSCANX(code); break;
        case 8: DSCAN(WS_H, (size_t)M * D_FF * 2, 1, code); break;
        }
#endif
    }
#if MK_DEBUG
    hipLaunchKernelGGL(dbg_fin, dim3(1024), dim3(512), 0, stream, (float*)d_out, (size_t)M * D, flag);
#endif
#else
    a.ph_lo = 0; a.ph_hi = NPHASES;
    (void)hipMemsetAsync((unsigned char*)d_ws + WS_BAR, 0, 16384, stream);
    void* args[] = {&a};
    hipError_t e = hipLaunchCooperativeKernel((const void*)mega, dim3(grid), dim3(NTHREADS), args, LDS_BYTES, stream);
    if (e != hipSuccess) fprintf(stderr, "cooperative launch failed: %s (grid %d)\n", hipGetErrorString(e), grid);
#endif
}
```

```cpp
#include <hip/hip_runtime.h>
#include <hip/hip_cooperative_groups.h>
#include <cstdio>
#include <cstdint>
namespace cg = cooperative_groups;

#ifndef MK_MULTI
#define MK_MULTI 0
#endif

constexpr int D = 1024, DEPTH = 4;
constexpr int M_P = 4 * 4096, M_S = 8 * 8192, M = M_P + M_S;
constexpr int NBATCH = 12;
constexpr int D_IN = 2576, D_INP = 2816, D_FF = 4096;
constexpr int NCHUNK = M / 64;
constexpr float ALPHA = 1.681792830507429f;
__host__ __device__ __forceinline__ int batch_of_row(int m) { return m < M_P ? (m >> 12) : 4 + ((m - M_P) >> 13); }
__host__ __device__ __forceinline__ void batch_info(int b, int& row0, int& S) { if (b < 4) { row0 = b << 12; S = 4096; } else { row0 = M_P + ((b - 4) << 13); S = 8192; } }
namespace pg8 {
#define PG8_LAS __attribute__((address_space(3)))
typedef unsigned short bf16_t;
typedef short bf16x8 __attribute__((ext_vector_type(8)));
typedef float f32x4 __attribute__((ext_vector_type(4)));
typedef unsigned u32x4 __attribute__((ext_vector_type(4)));
constexpr int BM = 256, BK = 64, HALF = 128, HTB = HALF * BK * 2  , STAGE_BYTES = 8 * HTB, NXCD = 8, WGM = 8;

__host__ __device__ __forceinline__ int lds_byte(int r, int c) { const int st = (r >> 4) * 2 + (c >> 5), rr = r & 15, cc = c & 31, ob = rr * 64 + cc * 2; return st * 1024 + (ob ^ (((ob >> 9) & 1) << 5)); }
__host__ __device__ __forceinline__ void stage_rc(int b, int& R, int& C) { const int st = b / 1024, sb = b % 1024, swz = sb ^ (((sb >> 9) & 1) << 5); R = (st >> 1) * 16 + swz / 64; C = (st & 1) * 32 + (swz % 64) / 2; }
__host__ __device__ __forceinline__ int perm32(int rho) { const int n = rho >> 4, i = rho & 15; return 8 * (i >> 2) + 4 * n + (i & 3); }

struct Unit { int pm, pn; };
struct Gemm { const bf16_t* A; const bf16_t* Bt; int M, N, K; };

struct StaticOrder {
    int nM, nN, nwg, G, c;
    __host__ __device__ void init(int M, int N, int G_, int c_) { nM = M / BM; nN = N / BM; nwg = nM * nN; G = G_; c = c_; }
    __host__ __device__ bool next(int i, Unit& u) const {
        const long L = (long)i * G + c; if (L >= nwg) return false;
        int wgid = (int)L; { const int q = nwg / NXCD, r = nwg % NXCD, xcd = wgid % NXCD, off = wgid / NXCD; wgid = (xcd < r ? xcd * (q + 1) : r * (q + 1) + (xcd - r) * q) + off; }
        const int nig = WGM * nN, gid = wgid / nig, fm = gid * WGM, gsz = (nM - fm) < WGM ? (nM - fm) : WGM;
        u.pm = fm + ((wgid % nig) % gsz); u.pn = (wgid % nig) / gsz; return true;
    }
    __device__ __forceinline__ void a_ready(const Unit&) const {}
    __device__ __forceinline__ void done(const Unit&) const {}
};

typedef __bf16 bf16x2_t __attribute__((ext_vector_type(2)));
typedef float f32x2_t __attribute__((ext_vector_type(2)));
__device__ __forceinline__ unsigned cvt_pk_bf16(float lo, float hi) { const f32x2_t v = {lo, hi}; const bf16x2_t b = __builtin_convertvector(v, bf16x2_t); return __builtin_bit_cast(unsigned, b); }
typedef float f32x2 __attribute__((ext_vector_type(2)));
struct EpiP {
    static constexpr bool PERM = true, AFTER_DRAIN = false;
    bf16_t* O;
    __device__ __forceinline__ void operator()(const f32x4 (&acc)[2][2][4][2], const Unit& u, int wr, int wc, int fr, int fq) const {
        const int row0 = u.pm * BM + wr * 64 + fr; const int col0 = u.pn * BM + wc * 32 + 8 * fq;
#pragma unroll
        for (int ai = 0; ai < 2; ++ai)
#pragma unroll
            for (int m = 0; m < 4; ++m) { bf16_t* rowp = O + (size_t)(row0 + ai * HALF + m * 16) * 2576 + col0;
#pragma unroll
                for (int bj = 0; bj < 2; ++bj) { if (col0 + bj * HALF < 2576) { const f32x4 v0 = acc[ai][bj][m][0], v1 = acc[ai][bj][m][1];
                    u32x4 w; w.x = cvt_pk_bf16(v0[0], v0[1]); w.y = cvt_pk_bf16(v0[2], v0[3]); w.z = cvt_pk_bf16(v1[0], v1[1]); w.w = cvt_pk_bf16(v1[2], v1[3]);
                    *(u32x4*)(rowp + bj * HALF) = w; } } }
    }
};
struct EpiH {
    static constexpr bool PERM = true, AFTER_DRAIN = false;
    bf16_t* O; const float* bias;
    __device__ __forceinline__ void operator()(const f32x4 (&acc)[2][2][4][2], const Unit& u, int wr, int wc, int fr, int fq) const {
        const int row0 = u.pm * BM + wr * 64 + fr; const int col0 = u.pn * BM + wc * 32 + 8 * fq;
        f32x4 bv[2][2];
#pragma unroll
        for (int bj = 0; bj < 2; ++bj)
#pragma unroll
            for (int n = 0; n < 2; ++n) bv[bj][n] = *(const f32x4*)(bias + col0 + bj * HALF + 4 * n);
#pragma unroll
        for (int ai = 0; ai < 2; ++ai)
#pragma unroll
            for (int m = 0; m < 4; ++m) { bf16_t* rowp = O + (size_t)(row0 + ai * HALF + m * 16) * 4096 + col0;
#pragma unroll
                for (int bj = 0; bj < 2; ++bj) { f32x4 v0 = acc[ai][bj][m][0] + bv[bj][0], v1 = acc[ai][bj][m][1] + bv[bj][1];
                    v0 = __builtin_elementwise_max(v0, (f32x4){0.f, 0.f, 0.f, 0.f}); v1 = __builtin_elementwise_max(v1, (f32x4){0.f, 0.f, 0.f, 0.f}); v0 = v0 * v0; v1 = v1 * v1;
                    u32x4 w; w.x = cvt_pk_bf16(v0[0], v0[1]); w.y = cvt_pk_bf16(v0[2], v0[3]); w.z = cvt_pk_bf16(v1[0], v1[1]); w.w = cvt_pk_bf16(v1[2], v1[3]);
                    *(u32x4*)(rowp + bj * HALF) = w; } }
    }
};
struct EpiRes {
    static constexpr bool PERM = false, AFTER_DRAIN = false;
    float* X; const float* gate  ; const float* bias  ;
    const float* stats  ; const float* gam; const float* bet;
    const float* src_p; const float* src_s;
    __device__ __forceinline__ void operator()(const f32x4 (&acc)[2][2][4][2], const Unit& u, int wr, int wc, int fr, int fq) const {
        const int row0 = u.pm * BM + wr * 64 + fr; const int col0 = u.pn * BM + wc * 32 + 4 * fq;
        const float* gb = gate + (size_t)batch_of_row(u.pm * BM) * 6144;
        const float* XS = src_p ? (u.pm * BM < M_P ? src_p : src_s - (size_t)M_P * 1024) : X;
#pragma unroll
        for (int bj = 0; bj < 2; ++bj) {
            f32x4 av[2], gv[2], cv[2];
#pragma unroll
            for (int n = 0; n < 2; ++n) { const int c = col0 + bj * HALF + n * 16;
                gv[n] = *(const f32x4*)(gb + c) + 1.0f;
                const f32x4 bv = bias ? *(const f32x4*)(bias + c) : (f32x4){0.f, 0.f, 0.f, 0.f};
                if (stats) { av[n] = *(const f32x4*)(gam + c) * ALPHA; cv[n] = *(const f32x4*)(bet + c) * ALPHA + gv[n] * bv; }
                else { av[n] = (f32x4){ALPHA, ALPHA, ALPHA, ALPHA}; cv[n] = gv[n] * bv; } }
#pragma unroll
            for (int ai = 0; ai < 2; ++ai)
#pragma unroll
                for (int mp = 0; mp < 2; ++mp) {
                    f32x4 xo[2][2]; f32x2 st[2];
#pragma unroll
                    for (int mm = 0; mm < 2; ++mm) { const int r = row0 + ai * HALF + (2 * mp + mm) * 16; const float* xp = XS + (size_t)r * 1024 + col0 + bj * HALF;
                        xo[mm][0] = *(const f32x4*)xp; xo[mm][1] = *(const f32x4*)(xp + 16);
                        st[mm] = stats ? *(const f32x2*)(stats + 2 * (size_t)r) : (f32x2){0.f, 1.f}; }
#pragma unroll
                    for (int mm = 0; mm < 2; ++mm) { const int m = 2 * mp + mm; const int r = row0 + ai * HALF + m * 16; float* xp = X + (size_t)r * 1024 + col0 + bj * HALF;
#pragma unroll
                        for (int n = 0; n < 2; ++n)
                            *(f32x4*)(xp + n * 16) = ((xo[mm][n] - st[mm].x) * st[mm].y) * av[n] + gv[n] * acc[ai][bj][m][n] + cv[n]; }
                    asm volatile("" ::: "memory");
                }
        }
    }
};
template <class Epi, class Sched, bool ALIGN_EPI = false, bool SP2 = false>
__device__ __forceinline__ void gemm_phase(PG8_LAS unsigned char* lds, const Gemm g, const Sched& S, const Epi& E, const int tid) {
    const int wid = __builtin_amdgcn_readfirstlane(tid >> 6), lane = tid & 63, wr = wid >> 2, wc = wid & 3, fr = lane & 15, fq = lane >> 4;
    const int K = g.K, nt = K / BK;
    unsigned voffA[2], voffB[2];
#pragma unroll
    for (int i = 0; i < 2; ++i) { int R, C; stage_rc(tid * 16 + i * 8192, R, C); const int Rb = Epi::PERM ? ((R & ~31) + perm32(R & 31)) : R;
        voffA[i] = (unsigned)(R * K + C) * 2u; voffB[i] = (unsigned)(Rb * K + C) * 2u; }
    const size_t kstep = (size_t)(BK * 2);
    const size_t hstep = (size_t)HALF * K * 2;
    const size_t tstep = 2 * hstep;
    const unsigned ldsw = (unsigned)wid * 1024u;
    const int aoff = lds_byte(wr * 64 + fr, fq * 8), boff = lds_byte(wc * 32 + fr, fq * 8);
#define PG8_SA(b, h) (((b) * 2 + (h)) * HTB)
#define PG8_SB(b, h) ((4 + (b) * 2 + (h)) * HTB)
#define PG8_STAGE(bufoff, gbase, voff) do { _Pragma("unroll") for (int _i = 0; _i < 2; ++_i) \
        __builtin_amdgcn_global_load_lds((const unsigned*)((const char*)(gbase) + (voff)[_i]), (PG8_LAS unsigned*)(lds + (bufoff) + ldsw + _i * 8192), 16, 0, 0); } while (0)
#define PG8_LDA(dst, b, h) do { _Pragma("unroll") for (int m = 0; m < 4; ++m) _Pragma("unroll") for (int k = 0; k < 2; ++k) dst[m][k] = *(const PG8_LAS bf16x8*)(lds + PG8_SA(b, h) + aoff + m * 2048 + k * 1024); } while (0)
#define PG8_LDB(dst, b, h) do { _Pragma("unroll") for (int n = 0; n < 2; ++n) _Pragma("unroll") for (int k = 0; k < 2; ++k) dst[n][k] = *(const PG8_LAS bf16x8*)(lds + PG8_SB(b, h) + boff + n * 2048 + k * 1024); } while (0)
#define PG8_MMA(ai, bj, At, Bt) do { __builtin_amdgcn_s_setprio(1); _Pragma("unroll") for (int m = 0; m < 4; ++m) _Pragma("unroll") for (int n = 0; n < 2; ++n) _Pragma("unroll") for (int k = 0; k < 2; ++k) \
        acc[ai][bj][m][n] = __builtin_amdgcn_mfma_f32_16x16x32_bf16(Bt[n][k], At[m][k], acc[ai][bj][m][n], 0, 0, 0); __builtin_amdgcn_s_setprio(0); } while (0)
#define PG8_WAIT_V(n) asm volatile("s_waitcnt vmcnt(" #n ")" ::: "memory")
#define PG8_WAIT_L(n) asm volatile("s_waitcnt lgkmcnt(" #n ")" ::: "memory")
#define PG8_BAR __builtin_amdgcn_s_barrier()
#define PG8_SCHED __builtin_amdgcn_sched_barrier(0)
    Unit cur, nxt; int ui = 0;
    if (!S.next(0, cur)) return;
    f32x4 acc[2][2][4][2];
#pragma unroll
    for (int a = 0; a < 2; ++a)
#pragma unroll
        for (int b = 0; b < 2; ++b)
#pragma unroll
            for (int m = 0; m < 4; ++m)
#pragma unroll
                for (int n = 0; n < 2; ++n) acc[a][b][m][n] = (f32x4){0.f, 0.f, 0.f, 0.f};
    bf16x8 At[4][2], B0[2][2], B1[2][2];
    const char* cA = (const char*)g.A + (size_t)cur.pm * tstep; const char* cB = (const char*)g.Bt + (size_t)cur.pn * tstep;
    S.a_ready(cur);
    if constexpr (SP2) {
        PG8_STAGE(PG8_SB(0, 0), cB, voffB); PG8_STAGE(PG8_SB(0, 1), cB + hstep, voffB); PG8_STAGE(PG8_SA(0, 0), cA, voffA); PG8_STAGE(PG8_SA(0, 1), cA + hstep, voffA);
        if (wr == 1) PG8_BAR;
        PG8_WAIT_V(2); PG8_BAR;
        PG8_STAGE(PG8_SB(1, 0), cB + kstep, voffB); PG8_STAGE(PG8_SA(1, 0), cA + kstep, voffA); PG8_STAGE(PG8_SB(1, 1), cB + hstep + kstep, voffB);
        PG8_WAIT_V(6); PG8_BAR;
    } else {
        PG8_STAGE(PG8_SB(0, 0), cB, voffB); PG8_STAGE(PG8_SA(0, 0), cA, voffA); PG8_STAGE(PG8_SB(0, 1), cB + hstep, voffB); PG8_STAGE(PG8_SA(0, 1), cA + hstep, voffA);
        if (wr == 1) PG8_BAR;
        PG8_WAIT_V(4); PG8_BAR;
        PG8_STAGE(PG8_SB(1, 0), cB + kstep, voffB); PG8_STAGE(PG8_SA(1, 0), cA + kstep, voffA); PG8_STAGE(PG8_SB(1, 1), cB + hstep + kstep, voffB);
        PG8_WAIT_V(6); PG8_BAR;
    }
    for (;;) {
        const bool has_next = S.next(ui + 1, nxt);
        const char* nA = has_next ? (const char*)g.A + (size_t)nxt.pm * tstep : cA; const char* nB = has_next ? (const char*)g.Bt + (size_t)nxt.pn * tstep : cB;
        for (int t = 0; t < nt; t += 2) {
            const bool last = (t == nt - 2);
            const char* a1 = cA + (size_t)(t + 1) * kstep;
            const char* a2 = last ? nA : cA + (size_t)(t + 2) * kstep; const char* b2 = last ? nB : cB + (size_t)(t + 2) * kstep;
            const char* a3 = a2 + kstep; const char* b3 = b2 + kstep;
            if (last && has_next) S.a_ready(nxt);
            if constexpr (SP2) {
            PG8_LDB(B0, 0, 0); PG8_LDB(B1, 0, 1); PG8_SCHED; PG8_LDA(At, 0, 0); PG8_STAGE(PG8_SA(1, 1), a1 + hstep, voffA);
            PG8_WAIT_V(8); PG8_WAIT_L(0); PG8_BAR; PG8_MMA(0, 0, At, B0); PG8_MMA(0, 1, At, B1); PG8_BAR; PG8_SCHED;
            PG8_LDA(At, 0, 1); PG8_STAGE(PG8_SB(0, 0), b2, voffB); PG8_STAGE(PG8_SB(0, 1), b2 + hstep, voffB); PG8_STAGE(PG8_SA(0, 0), a2, voffA);
            PG8_WAIT_V(8); PG8_WAIT_L(0); PG8_BAR; PG8_MMA(1, 0, At, B0); PG8_MMA(1, 1, At, B1); PG8_BAR; PG8_SCHED;
            PG8_LDB(B0, 1, 0); PG8_LDB(B1, 1, 1); PG8_SCHED; PG8_LDA(At, 1, 0); PG8_STAGE(PG8_SA(0, 1), a2 + hstep, voffA);
            PG8_WAIT_V(8); PG8_WAIT_L(0); PG8_BAR; PG8_MMA(0, 0, At, B0); PG8_MMA(0, 1, At, B1); PG8_BAR; PG8_SCHED;
            PG8_LDA(At, 1, 1); PG8_STAGE(PG8_SB(1, 0), b3, voffB); PG8_STAGE(PG8_SB(1, 1), b3 + hstep, voffB); PG8_STAGE(PG8_SA(1, 0), a3, voffA);
            PG8_WAIT_V(8); PG8_WAIT_L(0); PG8_BAR; PG8_MMA(1, 0, At, B0); PG8_MMA(1, 1, At, B1); PG8_BAR; PG8_SCHED;
            } else {
            PG8_LDB(B0, 0, 0); PG8_SCHED; PG8_LDA(At, 0, 0); PG8_STAGE(PG8_SA(1, 1), a1 + hstep, voffA);
            PG8_WAIT_L(8); PG8_BAR; PG8_WAIT_L(0); PG8_MMA(0, 0, At, B0); PG8_BAR; PG8_SCHED;
            PG8_LDB(B1, 0, 1); PG8_STAGE(PG8_SB(0, 0), b2, voffB);
            PG8_BAR; PG8_WAIT_L(0); PG8_MMA(0, 1, At, B1); PG8_BAR;
            PG8_LDA(At, 0, 1); PG8_STAGE(PG8_SA(0, 0), a2, voffA);
            PG8_BAR; PG8_WAIT_L(0); PG8_MMA(1, 0, At, B0); PG8_BAR; PG8_SCHED;
            PG8_STAGE(PG8_SB(0, 1), b2 + hstep, voffB);
            PG8_WAIT_V(6); PG8_BAR; PG8_MMA(1, 1, At, B1); PG8_BAR;
            PG8_LDB(B0, 1, 0); PG8_SCHED; PG8_LDA(At, 1, 0); PG8_STAGE(PG8_SA(0, 1), a2 + hstep, voffA);
            PG8_WAIT_L(8); PG8_BAR; PG8_WAIT_L(0); PG8_MMA(0, 0, At, B0); PG8_BAR; PG8_SCHED;
            PG8_LDB(B1, 1, 1); PG8_STAGE(PG8_SB(1, 0), b3, voffB);
            PG8_BAR; PG8_WAIT_L(0); PG8_MMA(0, 1, At, B1); PG8_BAR;
            PG8_LDA(At, 1, 1); PG8_STAGE(PG8_SA(1, 0), a3, voffA);
            PG8_BAR; PG8_WAIT_L(0); PG8_MMA(1, 0, At, B0); PG8_BAR; PG8_SCHED;
            PG8_STAGE(PG8_SB(1, 1), b3 + hstep, voffB);
            PG8_WAIT_V(6); PG8_BAR; PG8_MMA(1, 1, At, B1); PG8_BAR;
            }
        }
        if constexpr (ALIGN_EPI) { if (wr == 0) PG8_BAR; }
        if constexpr (!Epi::AFTER_DRAIN) { E(acc, cur, wr, wc, fr, fq); S.done(cur); }
        if (!has_next) break;
#pragma unroll
        for (int a = 0; a < 2; ++a)
#pragma unroll
            for (int b = 0; b < 2; ++b)
#pragma unroll
                for (int m = 0; m < 4; ++m)
#pragma unroll
                    for (int n = 0; n < 2; ++n) acc[a][b][m][n] = (f32x4){0.f, 0.f, 0.f, 0.f};
        cur = nxt; cA = nA; cB = nB; ++ui;
        if constexpr (ALIGN_EPI) { if (wr == 1) PG8_BAR; }
    }
    PG8_WAIT_V(0);
    if constexpr (!ALIGN_EPI) { if (wr == 0) PG8_BAR; }
    PG8_BAR;
    if constexpr (Epi::AFTER_DRAIN) { E.fused(acc, cur, wr, wc, fr, fq, lds, wid, lane); S.done(cur); }
#undef PG8_SA
#undef PG8_SB
#undef PG8_STAGE
#undef PG8_LDA
#undef PG8_LDB
#undef PG8_MMA
#undef PG8_WAIT_V
#undef PG8_WAIT_L
#undef PG8_BAR
#undef PG8_SCHED
}
}

#define GAS __attribute__((address_space(1)))
#define LAS __attribute__((address_space(3)))
typedef unsigned short bf16;
typedef unsigned v4u __attribute__((ext_vector_type(4)));
typedef unsigned v2u __attribute__((ext_vector_type(2)));
typedef float f32x4 __attribute__((ext_vector_type(4)));
typedef short bf16x8 __attribute__((ext_vector_type(8)));
constexpr int NTHREADS = 512;
constexpr int LDS_BYTES = 147456 + 64;
constexpr int NSCAN = 96;

constexpr size_t MiB = 1u << 20;
constexpr size_t WS_MOD = 0;
constexpr size_t WS_EGL = WS_MOD + (size_t)DEPTH * NBATCH * 6144 * 4;
constexpr size_t WS_STATS = 1310720;
constexpr size_t WS_WIN = 2 * MiB, WS_WOUT = WS_WIN + (size_t)D_INP * D * 2, WS_W1 = WS_WOUT + (size_t)D * D * 2, WS_W2 = WS_W1 + (size_t)D_FF * D * 2;
constexpr size_t WS_P = 26 * MiB;
constexpr size_t WS_H = 26 * MiB;
constexpr size_t WS_DNC = 429 * MiB;
constexpr size_t WS_QH = 749 * MiB, WS_EG = 789 * MiB;
constexpr size_t WS_WX = 792 * MiB;
constexpr size_t WS_END = 863 * MiB;
constexpr size_t WS_XN = 864 * MiB;
static_assert(WS_W2 + (size_t)D * D_FF * 2 <= WS_P && WS_P + (size_t)M * D_IN * 2 <= WS_DNC && WS_DNC + (size_t)NCHUNK * 8 * 32768 <= WS_QH && WS_EG + (size_t)NCHUNK * 8 * 64 * 4 <= WS_END && WS_H + (size_t)M * D_FF * 2 <= WS_XN && WS_XN + (size_t)M * D * 2 <= 1024 * MiB && WS_EGL + NCHUNK * 8 * 4 <= WS_STATS && WS_STATS + (size_t)M * 8 <= 1966080 && 1966080 + 16384 <= WS_WIN && WS_END + 64 <= WS_XN, "ws map");

__device__ __forceinline__ float bflo(unsigned u) { return __builtin_bit_cast(float, u << 16); }
__device__ __forceinline__ float bfhi(unsigned u) { return __builtin_bit_cast(float, u & 0xffff0000u); }
__device__ __forceinline__ float bf1(bf16 u) { return __builtin_bit_cast(float, (unsigned)u << 16); }
__device__ __forceinline__ unsigned pk2(float lo, float hi) { return pg8::cvt_pk_bf16(lo, hi); }
__device__ __forceinline__ bf16 f2bf(float v) { return __builtin_bit_cast(unsigned short, (__bf16)v); }
__device__ __forceinline__ float wave_sum(float v) {
#pragma unroll
    for (int o = 1; o < 64; o <<= 1) v += __shfl_xor(v, o);
    return v;
}
constexpr size_t LAYER_W_BYTES = (size_t)D_INP * D * 2 + (size_t)D * D * 2 + 2 * (size_t)D_FF * D * 2;
static_assert(WS_WX + 3 * LAYER_W_BYTES <= WS_END, "ws map (weights)");
__host__ __device__ __forceinline__ size_t wbase(int l) { return l == 0 ? 0 : (WS_WX - WS_WIN) + (size_t)(l - 1) * LAYER_W_BYTES; }
__device__ __forceinline__ int dmap(int p) { return 16 * ((p >> 2) & 1) + 4 * (p >> 3) + (p & 3); }
__device__ __forceinline__ int ppos(int d) { return 8 * ((d >> 2) & 3) + 4 * (d >> 4) + (d & 3); }
#define MFMA_BF16(a, b, c) __builtin_amdgcn_mfma_f32_16x16x32_bf16((a), (b), (c), 0, 0, 0)

struct Args { const float* in[26]; float* out; unsigned char* ws; int ph_lo, ph_hi; };

__device__ __forceinline__ void transpose_item(const float* W, int K, int N, bf16* WT, LAS float* scr, int item, int nblk, int lane) {
    const int kb = item / nblk, nb = item % nblk, k0 = 64 * kb, n0 = 32 * nb;
    const int nn = n0 + (lane & 31);
#pragma unroll 8
    for (int i = 0; i < 32; ++i) { const int kk = 2 * i + (lane >> 5); scr[kk * 33 + (lane & 31)] = nn < N ? W[(size_t)(k0 + kk) * N + nn] : 0.f; }
    asm volatile("s_waitcnt lgkmcnt(0)" ::: "memory");
    const int c = lane & 7;
#pragma unroll
    for (int j = 0; j < 4; ++j) { const int n = (lane >> 3) + 8 * j; const LAS float* s = scr + (8 * c) * 33 + n;
        v4u o; o.x = pk2(s[0 * 33], s[1 * 33]); o.y = pk2(s[2 * 33], s[3 * 33]); o.z = pk2(s[4 * 33], s[5 * 33]); o.w = pk2(s[6 * 33], s[7 * 33]);
        *(v4u*)(WT + (size_t)(n0 + n) * K + k0 + 8 * c) = o; }
    asm volatile("s_waitcnt lgkmcnt(0)" ::: "memory");
}
__device__ __forceinline__ void convert_layer(const Args& a, unsigned char* ws, int l, LAS unsigned char* lds, int gw, int NGW, int wave, int lane) {
    LAS float* scr = (LAS float*)(lds + wave * 16384);
    const float* Win = a.in[8] + (size_t)l * D * D_IN; const float* Wout = a.in[17] + (size_t)l * D * D;
    const float* W1 = a.in[20] + (size_t)l * D * D_FF; const float* W2 = a.in[22] + (size_t)l * D_FF * D;
    const size_t wb = wbase(l);
    bf16* WinT = (bf16*)(ws + WS_WIN + wb); bf16* WoutT = (bf16*)(ws + WS_WOUT + wb); bf16* W1T = (bf16*)(ws + WS_W1 + wb); bf16* W2T = (bf16*)(ws + WS_W2 + wb);
    constexpr int I_IN = 16 * 88, I_OUT = 16 * 32, I_1 = 16 * 128, I_2 = 64 * 32;
    for (int it = gw; it < I_IN + I_OUT + I_1 + I_2; it += NGW) {
        int r = it;
        if (r < I_IN) { transpose_item(Win, D, D_IN, WinT, scr, r, 88, lane); continue; } r -= I_IN;
        if (r < I_OUT) { transpose_item(Wout, D, D, WoutT, scr, r, 32, lane); continue; } r -= I_OUT;
        if (r < I_1) { transpose_item(W1, D, D_FF, W1T, scr, r, 128, lane); continue; } r -= I_1;
        transpose_item(W2, D_FF, D, W2T, scr, r, 32, lane);
    }
}
__device__ __forceinline__ void mod_phase(const Args& a, unsigned char* ws, LAS unsigned char* lds, int tid, int wave, int lane, int bid, int G) {
    LAS float* sc = (LAS float*)lds;
    LAS float* red = (LAS float*)(lds + 49152);
    float* modbuf = (float*)(ws + WS_MOD);
    for (int i = tid; i < NBATCH * 1024; i += NTHREADS) { const int b = i >> 10, k = i & 1023; const float c = b < 4 ? a.in[2][b * 1024 + k] : a.in[3][(b - 4) * 1024 + k]; sc[i] = c / (1.f + __expf(-c)); }
    __syncthreads();
    for (int unit = bid; unit < DEPTH * 96; unit += G) {
        const int l = unit / 96, jb = unit % 96;
        const float* W = a.in[6] + (size_t)l * D * 6144 + jb * 64 + lane;
        float acc[NBATCH];
#pragma unroll
        for (int b = 0; b < NBATCH; ++b) acc[b] = 0.f;
#pragma unroll 4
        for (int k = wave * 128; k < wave * 128 + 128; ++k) { const float w = W[(size_t)k * 6144];
#pragma unroll
            for (int b = 0; b < NBATCH; ++b) acc[b] += sc[b * 1024 + k] * w; }
#pragma unroll
        for (int b = 0; b < NBATCH; ++b) red[(wave * NBATCH + b) * 64 + lane] = acc[b];
        __syncthreads();
        for (int i = tid; i < NBATCH * 64; i += NTHREADS) { const int b = i >> 6, ln = i & 63; float s = 0.f;
#pragma unroll
            for (int w = 0; w < 8; ++w) s += red[(w * NBATCH + b) * 64 + ln];
            modbuf[(size_t)(l * NBATCH + b) * 6144 + jb * 64 + ln] = s + a.in[7][l * 6144 + jb * 64 + ln]; }
        __syncthreads();
    }
}

__device__ __forceinline__ void ln_rows(const float* xp, const float* xs, bool in_mode, float* X, const float* gam, const float* bet, const float* modl, int sh_off, bf16* XN, float* stats  , int gw, int NGW, int lane) {
#define LN_SRC(m_) (in_mode ? ((m_) < M_P ? xp + (size_t)(m_) * D : xs + (size_t)((m_) - M_P) * D) : X + (size_t)(m_) * D)
#define LN_LOAD(B_, m_) do { const int mq_ = (m_) < M ? (m_) : M - 1; const float* src_ = LN_SRC(mq_); _Pragma("unroll") for (int j = 0; j < 4; ++j) B_[j] = __builtin_nontemporal_load((const f32x4*)src_ + lane + 64 * j); } while (0)
    f32x4 bA[4], bB[4];
    LN_LOAD(bA, gw); LN_LOAD(bB, gw + NGW);
    auto process = [&](f32x4 (&buf)[4], int m) {
        f32x4 v[4]; float s = 0.f;
#pragma unroll
        for (int j = 0; j < 4; ++j) { v[j] = buf[j]; s += (v[j].x + v[j].y) + (v[j].z + v[j].w); }
        LN_LOAD(buf, m + 2 * NGW);
        const float mean = wave_sum(s) * (1.f / D); float s2 = 0.f;
#pragma unroll
        for (int j = 0; j < 4; ++j) { v[j] = v[j] - mean; s2 += (v[j].x * v[j].x + v[j].y * v[j].y) + (v[j].z * v[j].z + v[j].w * v[j].w); }
        const float rstd = 1.f / sqrtf(wave_sum(s2) * (1.f / D) + 1e-5f);
        const float* mrow = modl ? modl + (size_t)batch_of_row(m) * 6144 + sh_off : nullptr;
        if (stats && lane == 0) { stats[2 * (size_t)m] = mean; stats[2 * (size_t)m + 1] = rstd; }
#pragma unroll
        for (int j = 0; j < 4; ++j) { const int c4 = lane + 64 * j;
            const f32x4 y = v[j] * rstd * ((const f32x4*)gam)[c4] + ((const f32x4*)bet)[c4];
            if (!stats) ((f32x4*)(X + (size_t)m * D))[c4] = y;
            if (XN) { const f32x4 h = y * (((const f32x4*)(mrow + 1024))[c4] + 1.0f) + ((const f32x4*)mrow)[c4];
                v2u w; w.x = pk2(h.x, h.y); w.y = pk2(h.z, h.w); ((v2u*)(XN + (size_t)m * D))[c4] = w; } }
    };
#pragma unroll 1
    for (int m = gw; m < M; m += 2 * NGW) { process(bA, m); if (m + NGW < M) process(bB, m + NGW); }
#undef LN_LOAD
#undef LN_SRC
}

__device__ __forceinline__ void conv_items(const bf16* P, bf16* mix, const float* cw  , int first, int stride) {
    const int c0 = (first & 31) * 8;
    f32x4 wt[3][2];
#pragma unroll
    for (int k = 0; k < 3; ++k) { wt[k][0] = *(const f32x4*)(cw + k * 256 + c0); wt[k][1] = *(const f32x4*)(cw + k * 256 + c0 + 4); }
#pragma unroll 2
    for (int it = first; it < M * 32; it += stride) {
        const int m = it >> 5;
        const int b = batch_of_row(m); int row0, S; batch_info(b, row0, S); const int t = m - row0;
        const bf16* pr = P + (size_t)m * D_IN + c0;
        const v4u zz = {0u, 0u, 0u, 0u};
        const v4u bg = *(const v4u*)pr;
        const v4u c1 = *(const v4u*)(pr + 256), u1 = *(const v4u*)(pr + 512);
        const v4u cm = t > 0 ? *(const v4u*)(pr - D_IN + 256) : zz, um = t > 0 ? *(const v4u*)(pr - D_IN + 512) : zz;
        const v4u cp = t < S - 1 ? *(const v4u*)(pr + D_IN + 256) : zz, up = t < S - 1 ? *(const v4u*)(pr + D_IN + 512) : zz;
        v4u o;
#pragma unroll
        for (int e = 0; e < 4; ++e) {
            const float w0l = wt[0][e >> 1][(2 * e) & 3], w0h = wt[0][e >> 1][(2 * e + 1) & 3], w1l = wt[1][e >> 1][(2 * e) & 3], w1h = wt[1][e >> 1][(2 * e + 1) & 3], w2l = wt[2][e >> 1][(2 * e) & 3], w2h = wt[2][e >> 1][(2 * e + 1) & 3];
            const float yl = bflo(bg[e]) * (w0l * bflo(cm[e]) * bflo(um[e]) + w1l * bflo(c1[e]) * bflo(u1[e]) + w2l * bflo(cp[e]) * bflo(up[e]));
            const float yh = bfhi(bg[e]) * (w0h * bfhi(cm[e]) * bfhi(um[e]) + w1h * bfhi(c1[e]) * bfhi(u1[e]) + w2h * bfhi(cp[e]) * bfhi(up[e]));
            o[e] = pk2(yl, yh);
        }
        *(v4u*)(mix + (size_t)m * D + c0) = o;
    }
}

__device__ __forceinline__ void attn_unit(const bf16* P, bf16* mix, const float* sinkl, int u, LAS unsigned char* lds, int tid, int wave, int lane) {
    int b, r;
    if (u < 256) { b = u >> 6; r = u & 63; } else { b = 4 + ((u - 256) >> 7); r = (u - 256) & 127; }
    const int qb = r >> 1, hk = r & 1;
    int row0, S; batch_info(b, row0, S);
    const int q0 = qb * 128;
    LAS bf16* Ks = (LAS bf16*)lds;
    LAS bf16* Vt = (LAS bf16*)(lds + 57600);
    const int fr = lane & 15, fq = lane >> 4;
    const int qa = q0 + 16 * wave;
    const size_t qrow = (size_t)(row0 + qa + fr);
    bf16x8 qfn[2];
#pragma unroll
    for (int ks = 0; ks < 2; ++ks) qfn[ks] = *(const bf16x8*)(P + qrow * D_IN + 768 + (hk * 4) * 64 + 32 * ks + 8 * fq);
    {
        v4u kvr[7], vvr[7];
#pragma unroll
        for (int r = 0; r < 7; ++r) { const int idx = tid + NTHREADS * r; const int dg = idx / 400, kk = idx - dg * 400; const int t = q0 - 128 + kk;
            kvr[r] = (v4u){0u, 0u, 0u, 0u}; vvr[r] = (v4u){0u, 0u, 0u, 0u};
            if (idx < 3200 && t >= 0 && t < S) { const bf16* pr = P + (size_t)(row0 + t) * D_IN + 1280 + hk * 64 + dg * 8; kvr[r] = *(const v4u*)pr; vvr[r] = *(const v4u*)(pr + 128); } }
#pragma unroll
        for (int r = 0; r < 7; ++r) { const int idx = tid + NTHREADS * r; const int dg = idx / 400, kk = idx - dg * 400;
            if (idx < 3200) { *(LAS v4u*)(Ks + kk * 72 + dg * 8) = kvr[r];
#pragma unroll
                for (int e = 0; e < 4; ++e) { Vt[(dg * 8 + 2 * e) * 408 + kk] = (bf16)(vvr[r][e] & 0xffffu); Vt[(dg * 8 + 2 * e + 1) * 408 + kk] = (bf16)(vvr[r][e] >> 16); } } }
    }
    __syncthreads();
#pragma unroll 1
    for (int g = 0; g < 4; ++g) {
        const int h = hk * 4 + g;
        int frl = fr; asm volatile("" : "+v"(frl));
        const float LOG2E = 1.4426950408889634f;
        const float nslope = -exp2f(-(float)(h + 1)) * LOG2E, qs = 0.125f * LOG2E; const float sink2 = sinkl[h] * LOG2E;
        const float relb = (float)(4 * fq - 128 - frl);
        const float rlo = fmaxf(-128.f, -(float)(qa + frl)), rhi = fminf(128.f, (float)(S - 1 - qa - frl));
        const float mid = 0.5f * (rlo + rhi), half = 0.5f * (rhi - rlo);
        bf16x8 qf[2];
#pragma unroll
        for (int ks = 0; ks < 2; ++ks) qf[ks] = qfn[ks];
        { const int hn = h < hk * 4 + 3 ? h + 1 : h;
#pragma unroll
          for (int ks = 0; ks < 2; ++ks) qfn[ks] = *(const bf16x8*)(P + qrow * D_IN + 768 + hn * 64 + 32 * ks + 8 * fq); }
        float sc[18][4]; float mx = -INFINITY;
#pragma unroll
        for (int kt = 0; kt < 17; ++kt) {
            f32x4 acc = {0.f, 0.f, 0.f, 0.f};
#pragma unroll
            for (int ks = 0; ks < 2; ++ks) { const bf16x8 kf = *(const LAS bf16x8*)(Ks + (16 * wave + 16 * kt + fr) * 72 + 32 * ks + 8 * fq); acc = MFMA_BF16(kf, qf[ks], acc); }
#pragma unroll
            for (int j = 0; j < 4; ++j) { const float relf = relb + (float)(16 * kt + j);
                const float t = __builtin_fmaf(fabsf(relf), nslope, acc[j] * qs);
                const float s2 = fabsf(relf - mid) <= half ? t : -INFINITY; sc[kt][j] = s2; mx = fmaxf(mx, s2); }
            if (kt & 1) __builtin_amdgcn_sched_barrier(0);
        }
        mx = fmaxf(mx, __shfl_xor(mx, 16)); mx = fmaxf(mx, __shfl_xor(mx, 32));
        const float mm = fmaxf(mx, sink2);
        float sum = 0.f;
#pragma unroll
        for (int kt = 0; kt < 17; ++kt)
#pragma unroll
            for (int j = 0; j < 4; ++j) { const float e = __builtin_amdgcn_exp2f(sc[kt][j] - mm); sc[kt][j] = e; sum += e; }
#pragma unroll
        for (int j = 0; j < 4; ++j) sc[17][j] = 0.f;
        sum += __shfl_xor(sum, 16); sum += __shfl_xor(sum, 32);
        const float inv = 1.f / (sum + __builtin_amdgcn_exp2f(sink2 - mm));
        bf16x8 pb[9];
#pragma unroll
        for (int c = 0; c < 9; ++c) { v4u w; w.x = pk2(sc[2 * c][0], sc[2 * c][1]); w.y = pk2(sc[2 * c][2], sc[2 * c][3]);
            w.z = pk2(sc[2 * c + 1][0], sc[2 * c + 1][1]); w.w = pk2(sc[2 * c + 1][2], sc[2 * c + 1][3]); pb[c] = __builtin_bit_cast(bf16x8, w); }
#pragma unroll 1
        for (int dt = 0; dt < 4; ++dt) {
            f32x4 acc = {0.f, 0.f, 0.f, 0.f};
#pragma unroll
            for (int c = 0; c < 9; ++c) { const LAS bf16* vp = Vt + (16 * dt + fr) * 408 + 16 * wave + 32 * c + 4 * fq;
                const v2u lo = *(const LAS v2u*)vp, hi = *(const LAS v2u*)(vp + 16);
                v4u w; w.x = lo.x; w.y = lo.y; w.z = hi.x; w.w = hi.y; acc = MFMA_BF16(__builtin_bit_cast(bf16x8, w), pb[c], acc); }
            v2u w; w.x = pk2(acc[0] * inv, acc[1] * inv); w.y = pk2(acc[2] * inv, acc[3] * inv);
            *(v2u*)(mix + qrow * D + 256 + h * 64 + 16 * dt + 4 * fq) = w;
        }
    }
    __syncthreads();
}

__device__ __forceinline__ void dn_prep(const Args& a, unsigned char* ws, int l, LAS unsigned char* lds, int tid, int wave, int lane, int bid, int G) {
    const bf16* P = (const bf16*)(ws + WS_P);
    bf16* dnc = (bf16*)(ws + WS_DNC); bf16* qhat = (bf16*)(ws + WS_QH); float* eg = (float*)(ws + WS_EG); float* egl = (float*)(ws + WS_EGL);
    bf16* negw = dnc, *Am = dnc + 4096, *kdT = dnc + 8192, *uT = dnc + 12288;
    LAS float* qh = (LAS float*)lds;
    LAS float* kh = qh + 64 * 65;
    LAS float* vv = kh + 64 * 65;
    LAS float* Ls = (LAS float*)(lds + 49920);
    LAS float* gcs = (LAS float*)(lds + 82688);
    LAS float* bts = gcs + 128;
    LAS float* bws = bts + 128;
    LAS float* cws = bws + 128;
    const int fr = lane & 15, fq = lane >> 4;
#define LBAR() do { asm volatile("s_waitcnt lgkmcnt(0)" ::: "memory"); __builtin_amdgcn_s_barrier(); asm volatile("" ::: "memory"); } while (0)
    const int NU = NCHUNK * 4;
    LAS unsigned char* rawb = lds + 86528;
    unsigned ga = 0, gb = 0;
    auto load_unit = [&](int unit) {
        const int cgi = unit >> 2, h = unit & 3; const int rowc = cgi * 64;
        const int b = batch_of_row(rowc); int row0, S; batch_info(b, row0, S);
        const int t0 = rowc - row0;
#pragma unroll
        for (int r = 0; r < 4; ++r) { const int p = tid + NTHREADS * r;
            if (p < 1584) { const int rr = p / 24, c = p % 24; int t = t0 - 1 + rr; t = t < 0 ? 0 : (t > S - 1 ? S - 1 : t);
                __builtin_amdgcn_global_load_lds((const unsigned*)(P + (size_t)(row0 + t) * D_IN + 1536 + (c >> 3) * 256 + h * 64 + (c & 7) * 8), (LAS unsigned*)(rawb + r * 8192 + wave * 1024), 16, 0, 0); } }
        if (wave < 2) { const int io = wave ? 63 - lane : lane; const bf16* pg = P + (size_t)(rowc + io) * D_IN + 2560 + h; ga = pg[wave * 4]; gb = pg[8 + wave * 4]; }
    };
    int h_loaded = -1;
    if (bid < NU) load_unit(bid);
    asm volatile("s_waitcnt vmcnt(0)" ::: "memory"); LBAR();
    for (int unit = bid; unit < NU; unit += G) {
        const int cgi = unit >> 2, h = unit & 3;
        const int rowc = cgi * 64;
        const size_t cid0 = ((size_t)cgi * 4 + h) * 2;
        int S, t0; { const int b = batch_of_row(rowc); int row0; batch_info(b, row0, S); t0 = rowc - row0; }
        if (h != h_loaded) {
            for (int i = tid; i < 576; i += NTHREADS) { const int k = i / 192, r = i % 192; cws[i] = a.in[11][(size_t)l * 2304 + k * 768 + (r >> 6) * 256 + h * 64 + (r & 63)]; }
            h_loaded = h; LBAR();
        }
        const unsigned gca = ga, gcb = gb;
        { const int i = tid >> 3, dg = tid & 7; const int t = t0 + i;
          const v4u zz = {0u, 0u, 0u, 0u};
#pragma unroll
          for (int wq = 0; wq < 3; ++wq) {
              const LAS unsigned char* rp = rawb + ((i * 24) + wq * 8 + dg) * 16;
              const v4u r0 = t > 0 ? *(const LAS v4u*)rp : zz, r1 = *(const LAS v4u*)(rp + 384), r2 = t < S - 1 ? *(const LAS v4u*)(rp + 768) : zz;
              LAS float* dst = (wq == 0 ? qh : (wq == 1 ? kh : vv)) + i * 65 + dg * 8;
              const LAS float* c0 = cws + wq * 64 + dg * 8;
#pragma unroll
              for (int e = 0; e < 4; ++e) {
                  float yl = c0[2 * e] * bflo(r0[e]) + c0[192 + 2 * e] * bflo(r1[e]) + c0[384 + 2 * e] * bflo(r2[e]);
                  float yh = c0[2 * e + 1] * bfhi(r0[e]) + c0[192 + 2 * e + 1] * bfhi(r1[e]) + c0[384 + 2 * e + 1] * bfhi(r2[e]);
                  dst[2 * e] = yl / (1.f + __expf(-yl)); dst[2 * e + 1] = yh / (1.f + __expf(-yh));
              }
          } }
        LBAR();
        if (unit + G < NU) load_unit(unit + G);
        { const int pair = tid >> 2, sub = tid & 3, which = pair >> 6, i = pair & 63;
          LAS float* rowp = (which ? kh : qh) + i * 65 + sub * 16;
          float vals[16]; float s = 0.f;
#pragma unroll
          for (int e = 0; e < 16; ++e) { vals[e] = rowp[e]; s += vals[e] * vals[e]; }
          s += __shfl_xor(s, 1); s += __shfl_xor(s, 2);
          const float rs = (1.f / sqrtf(s + 1e-6f)) * (which ? 1.f : 0.125f);
#pragma unroll
          for (int e = 0; e < 16; ++e) rowp[e] = vals[e] * rs; }
        if (wave < 2) { const int dir = wave, ip = lane, io = dir ? 63 - ip : ip;
          const float av = bf1((bf16)gca), bv = bf1((bf16)gcb); (void)io;
          const float alog = a.in[12 + dir][l * 4 + h], dtb = a.in[14 + dir][l * 4 + h];
          const float xx = av + dtb; const float sp = xx > 20.f ? xx : __logf(1.f + __expf(xx));
          const float gg = -__expf(alog) * sp; const float beta = 1.f / (1.f + __expf(-bv));
          float c = gg;
#pragma unroll
          for (int off = 1; off < 64; off <<= 1) { const float tt = __shfl_up(c, off); if (lane >= off) c += tt; }
          gcs[dir * 64 + ip] = c; bts[dir * 64 + ip] = beta; bws[dir * 64 + ip] = beta * __expf(c); }
        LBAR();
        { const int which = wave >> 2, ti = wave & 3;
          const LAS float* Arow = (which ? qh : kh) + (16 * ti + fr) * 65;
          f32x4 acc[4];
#pragma unroll
          for (int tj = 0; tj < 4; ++tj) acc[tj] = (f32x4){0.f, 0.f, 0.f, 0.f};
#pragma unroll
          for (int kk = 0; kk < 16; ++kk) { const float av = Arow[4 * kk + fq];
#pragma unroll
              for (int tj = 0; tj < 4; ++tj) { const float bv = kh[(16 * tj + fr) * 65 + 4 * kk + fq]; acc[tj] = __builtin_amdgcn_mfma_f32_16x16x4f32(av, bv, acc[tj], 0, 0, 0); } }
#pragma unroll
          for (int tj = 0; tj < 4; ++tj)
#pragma unroll
              for (int j = 0; j < 4; ++j) { const int i = 16 * ti + 4 * fq + j, jc = 16 * tj + fr, i1 = 63 - i, j1 = 63 - jc; const float val = acc[tj][j];
                  if (which == 0) {
                      const float d0 = jc < i ? gcs[i] - gcs[jc] : 0.f, d1 = j1 < i1 ? gcs[64 + i1] - gcs[64 + j1] : 0.f;
                      Ls[i * 64 + jc] = jc < i ? bts[i] * val * __expf(d0) : 0.f;
                      Ls[4096 + i1 * 64 + j1] = j1 < i1 ? bts[64 + i1] * val * __expf(d1) : 0.f;
                  } else {
                      const float d0 = jc <= i ? gcs[i] - gcs[jc] : 0.f, d1 = j1 <= i1 ? gcs[64 + i1] - gcs[64 + j1] : 0.f;
                      Am[cid0 * 16384 + i * 64 + (jc & 32) + ppos(jc & 31)] = f2bf(jc <= i ? val * __expf(d0) : 0.f);
                      Am[(cid0 + 1) * 16384 + i1 * 64 + (j1 & 32) + ppos(j1 & 31)] = f2bf(j1 <= i1 ? val * __expf(d1) : 0.f);
                  } } }
        asm volatile("s_waitcnt vmcnt(0)" ::: "memory");
        LBAR();
        int tid4 = tid; asm volatile("" : "+v"(tid4));
        if (wave < 4) {
            const int dir = wave >> 1, col = tid4 & 127; const bool isW = (wave & 1) != 0;
            int st = dir ? -65 : 65; asm volatile("" : "+v"(st));
            const LAS float* sp = (isW ? kh + (col - 64) : vv + col) + (dir ? 63 * 65 : 0);
            const LAS float* scl = (isW ? bws : bts) + dir * 64;
            const LAS float* Lr = Ls + dir * 4096;
            const size_t cid = cid0 + dir;
            float x[64];
#pragma unroll
            for (int i = 0; i < 64; ++i) x[i] = 0.f;
#pragma unroll
            for (int i = 0; i < 64; ++i) {
                f32x4 lb[16];
                float acc = scl[i] * *sp; sp += st;
#pragma unroll
                for (int j4 = 0; j4 < (i + 3) / 4; ++j4) lb[j4] = *(const LAS f32x4*)(Lr + i * 64 + 4 * j4);
                __builtin_amdgcn_sched_barrier(0);
#pragma unroll
                for (int j4 = 0; j4 < (i + 3) / 4; ++j4) { const f32x4 l4 = lb[j4];
                    acc -= l4.x * x[4 * j4]; acc -= l4.y * x[4 * j4 + 1]; acc -= l4.z * x[4 * j4 + 2]; acc -= l4.w * x[4 * j4 + 3]; }
                x[i] = acc;
                __builtin_amdgcn_sched_barrier(0);
            }
            if (!isW) {
                bf16* dst = uT + cid * 16384 + col * 64;
#pragma unroll
                for (int q = 0; q < 8; ++q) { v4u w; w.x = pk2(x[8 * q], x[8 * q + 1]); w.y = pk2(x[8 * q + 2], x[8 * q + 3]); w.z = pk2(x[8 * q + 4], x[8 * q + 5]); w.w = pk2(x[8 * q + 6], x[8 * q + 7]); *(v4u*)(dst + 8 * q) = w; }
            } else {
                const int dk = col - 64; bf16* dst = negw + cid * 16384 + (dk & 32) + ppos(dk & 31);
#pragma unroll
                for (int i = 0; i < 64; ++i) dst[i * 64] = f2bf(-x[i]);
            }
        } else {
            const int t2 = tid4 - 256; const int lane4 = tid4 & 63;
            { const int i = t2 >> 2, part = t2 & 3, g32 = (part >> 1) * 32, pb = (part & 1) * 16;
              const LAS float* qr = qh + i * 65 + g32;
              v4u w0, w1;
#pragma unroll
              for (int e = 0; e < 4; ++e) { w0[e] = pk2(qr[dmap(pb + 2 * e)], qr[dmap(pb + 2 * e + 1)]); w1[e] = pk2(qr[dmap(pb + 8 + 2 * e)], qr[dmap(pb + 8 + 2 * e + 1)]); }
              bf16* dst = qhat + (size_t)(rowc + i) * 256 + h * 64 + 16 * part; *(v4u*)dst = w0; *(v4u*)(dst + 8) = w1; }
            const int dir = (wave - 4) >> 1; const size_t cid = cid0 + dir;
            if (((wave - 4) & 1) == 0) {
                const int dk = lane4; const float gl = gcs[dir * 64 + 63];
                int st = dir ? -65 : 65; asm volatile("" : "+v"(st));
                const LAS float* kb = kh + dk + (dir ? 63 * 65 : 0);
                bf16* dst = kdT + cid * 16384 + dk * 64;
#pragma unroll
                for (int q = 0; q < 8; ++q) { float vals[8];
#pragma unroll
                    for (int e = 0; e < 8; ++e) { const int pos = 8 * q + e; const int ip = (pos & 32) + dmap(pos & 31); vals[e] = kb[ip * st] * __expf(gl - gcs[dir * 64 + ip]); }
                    v4u w; w.x = pk2(vals[0], vals[1]); w.y = pk2(vals[2], vals[3]); w.z = pk2(vals[4], vals[5]); w.w = pk2(vals[6], vals[7]); *(v4u*)(dst + 8 * q) = w; }
            } else {
                const float e = __expf(gcs[dir * 64 + lane4]); eg[cid * 64 + lane4] = e; if (lane4 == 63) egl[cid] = e;
            }
        }
        LBAR();
    }
}

__device__ __forceinline__ void dn_scan_block(unsigned char* ws, int ch, LAS unsigned char* lds, int wave, int lane) {
    bf16* P = (bf16*)(ws + WS_P);
    const bf16* uT = (const bf16*)(ws + WS_DNC) + 12288; const float* eg = (const float*)(ws + WS_EG); const float* egl = (const float*)(ws + WS_EGL);
    int b, h, dir;
    if (ch < 64) { b = 4 + (ch >> 3); h = (ch >> 1) & 3; dir = ch & 1; } else { const int c2 = ch - 64; b = c2 >> 3; h = (c2 >> 1) & 3; dir = c2 & 1; }
    int row0, S; batch_info(b, row0, S);
    const int N = S >> 6, chunk0 = row0 >> 6;
    const int fr = lane & 15, fq = lane >> 4;
#define SCAN_CID(n_) (((size_t)(chunk0 + (dir ? N - 1 - (n_) : (n_))) * 4 + h) * 2 + dir)
    auto flush_o = [&](int n, int lw) {
        const size_t cid = SCAN_CID(n); const int rowc = (int)(cid >> 3) * 64;
        const LAS unsigned char* ob = lds + 131072 + (n & 1) * 8192;
#pragma unroll
        for (int r = 0; r < 2; ++r) { const int tl = lw * 16 + r * 8 + (lane >> 3), c8 = (lane & 7) * 8;
            const v4u w = *(const LAS v4u*)(ob + tl * 128 + c8 * 2);
            *(v4u*)(P + (size_t)(rowc + (dir ? 63 - tl : tl)) * D_IN + 1536 + dir * 256 + h * 64 + c8) = w; }
    };
    if (wave >= 4) {
        const int lw = wave - 4;
        const unsigned char* abase = ws + WS_DNC + (lw == 0 ? 0 : (lw == 2 ? 8192 : 16384));
        const unsigned lane_off = (unsigned)(fr * 128 + fq * 16);
        auto issue = [&](int n) {
            const int nn = n < N ? n : N - 1;
            const size_t cid = SCAN_CID(nn);
            LAS unsigned char* dst = lds + (nn & 3) * 32768 + lw * 8192;
            if (lw != 1) {
                const unsigned char* src = abase + cid * 32768 + lane_off;
#pragma unroll
                for (int m = 0; m < 4; ++m)
#pragma unroll
                    for (int ks = 0; ks < 2; ++ks)
                        __builtin_amdgcn_global_load_lds((const unsigned*)(src + m * 2048 + ks * 64), (LAS unsigned*)(dst + (m * 2 + ks) * 1024), 16, 0, 0);
            } else {
                const int rowc = (int)(cid >> 3) * 64;
#pragma unroll
                for (int m = 0; m < 4; ++m) { const int tl = 16 * m + fr; const unsigned char* src = ws + WS_QH + (size_t)(rowc + (dir ? 63 - tl : tl)) * 512 + h * 128 + fq * 16;
#pragma unroll
                    for (int ks = 0; ks < 2; ++ks)
                        __builtin_amdgcn_global_load_lds((const unsigned*)(src + ks * 64), (LAS unsigned*)(dst + (m * 2 + ks) * 1024), 16, 0, 0); }
            }
        };
        issue(0); issue(1); issue(2);
        asm volatile("s_waitcnt vmcnt(16)" ::: "memory"); __builtin_amdgcn_s_barrier(); asm volatile("" ::: "memory");
        for (int n = 0; n < N; ++n) {
            issue(n + 3);
            asm volatile("s_waitcnt vmcnt(16)" ::: "memory"); __builtin_amdgcn_s_barrier(); asm volatile("" ::: "memory");
        }
        asm volatile("s_waitcnt vmcnt(0)" ::: "memory");
    } else {
        const int e0 = 16 * wave;
        f32x4 St[4];
#pragma unroll
        for (int dt = 0; dt < 4; ++dt) St[dt] = (f32x4){0.f, 0.f, 0.f, 0.f};
        int vz = 0; asm volatile("" : "+v"(vz));
        struct Priv { v2u ur[4]; f32x4 eg[4]; float el; };
        Priv b0, b1, b2, b3;
#define SCAN_LDP(n_, B_) do { const int nq_ = (n_) < N ? (n_) : N - 1; const size_t cq_ = SCAN_CID(nq_); \
        _Pragma("unroll") for (int m = 0; m < 4; ++m) { B_.ur[m] = *(const v2u*)(uT + cq_ * 16384 + (e0 + fr) * 64 + 16 * m + 4 * fq); B_.eg[m] = *(const f32x4*)(eg + cq_ * 64 + 16 * m + 4 * fq); } \
        B_.el = egl[cq_ + vz]; } while (0)
        SCAN_LDP(0, b0); SCAN_LDP(1, b1); SCAN_LDP(2, b2);
#define SCAN_PIN(B_) do { _Pragma("unroll") for (int m = 0; m < 4; ++m) asm volatile("" : "+v"(B_.ur[m]), "+v"(B_.eg[m])); asm volatile("" : "+v"(B_.el)); } while (0)
        SCAN_PIN(b0); SCAN_PIN(b1); SCAN_PIN(b2);
        asm volatile("" ::: "memory"); __builtin_amdgcn_s_barrier(); asm volatile("" ::: "memory");
        auto body = [&](int n, const Priv& cur, Priv& nxt) {
            if (n > 0) flush_o(n - 1, wave);
            SCAN_LDP(n + 3, nxt);
            const LAS unsigned char* st = lds + (n & 3) * 32768 + lane * 16;
#define FRAG(arr, m, ks) (*(const LAS bf16x8*)(st + (arr) * 8192 + ((m) * 2 + (ks)) * 1024))
            bf16x8 Sb[2], Vb[2];
            bf16x8 fa[4][2], fb[4][2];
#pragma unroll
            for (int m = 0; m < 4; ++m)
#pragma unroll
                for (int ks = 0; ks < 2; ++ks) { fa[m][ks] = FRAG(0, m, ks); fb[m][ks] = FRAG(1, m, ks); }
#pragma unroll
            for (int ks = 0; ks < 2; ++ks) { v4u w; w.x = pk2(St[2 * ks][0], St[2 * ks][1]); w.y = pk2(St[2 * ks][2], St[2 * ks][3]); w.z = pk2(St[2 * ks + 1][0], St[2 * ks + 1][1]); w.w = pk2(St[2 * ks + 1][2], St[2 * ks + 1][3]); Sb[ks] = __builtin_bit_cast(bf16x8, w); }
            __builtin_amdgcn_sched_barrier(0);
            f32x4 vn[4], oo[4];
#pragma unroll
            for (int m = 0; m < 4; ++m) {
                f32x4 acc = {bflo(cur.ur[m].x), bfhi(cur.ur[m].x), bflo(cur.ur[m].y), bfhi(cur.ur[m].y)};
                acc = MFMA_BF16(fa[m][0], Sb[0], acc); acc = MFMA_BF16(fa[m][1], Sb[1], acc); vn[m] = acc;
                f32x4 o = {0.f, 0.f, 0.f, 0.f};
                o = MFMA_BF16(fb[m][0], Sb[0], o); o = MFMA_BF16(fb[m][1], Sb[1], o); oo[m] = o * cur.eg[m];
            }
#pragma unroll
            for (int m = 0; m < 4; ++m)
#pragma unroll
                for (int ks = 0; ks < 2; ++ks) { fa[m][ks] = FRAG(3, m, ks); fb[m][ks] = FRAG(2, m, ks); }
            __builtin_amdgcn_sched_barrier(0);
#pragma unroll
            for (int ks = 0; ks < 2; ++ks) { v4u w; w.x = pk2(vn[2 * ks][0], vn[2 * ks][1]); w.y = pk2(vn[2 * ks][2], vn[2 * ks][3]); w.z = pk2(vn[2 * ks + 1][0], vn[2 * ks + 1][1]); w.w = pk2(vn[2 * ks + 1][2], vn[2 * ks + 1][3]); Vb[ks] = __builtin_bit_cast(bf16x8, w); }
#pragma unroll
            for (int dt = 0; dt < 4; ++dt) { f32x4 s2 = St[dt] * cur.el; s2 = MFMA_BF16(fa[dt][0], Vb[0], s2); s2 = MFMA_BF16(fa[dt][1], Vb[1], s2); St[dt] = s2; }
            LAS bf16* ob = (LAS bf16*)(lds + 131072 + (n & 1) * 8192) + e0 + fr;
#pragma unroll
            for (int m = 0; m < 4; ++m) {
                f32x4 o = oo[m]; o = MFMA_BF16(fb[m][0], Vb[0], o); o = MFMA_BF16(fb[m][1], Vb[1], o);
#pragma unroll
                for (int j = 0; j < 4; ++j) ob[(16 * m + 4 * fq + j) * 64] = f2bf(o[j]);
            }
#undef FRAG
            asm volatile("s_waitcnt lgkmcnt(0)" ::: "memory"); __builtin_amdgcn_s_barrier(); asm volatile("" ::: "memory");
        };
#pragma unroll 1
        for (int n = 0; n < N; n += 4) { body(n, b0, b3); body(n + 1, b1, b0); body(n + 2, b2, b1); body(n + 3, b3, b2); }
        flush_o(N - 1, wave);
    }
#undef SCAN_LDP
#undef SCAN_PIN
#undef SCAN_CID
}

__device__ __forceinline__ void dn_post(const bf16* P, bf16* mix, const float* ng  , int gw, int NGW, int lane) {
    const int half = lane >> 5, c = (lane & 31) * 8;
    const f32x4 g0 = *(const f32x4*)(ng + (c & 63)), g1 = *(const f32x4*)(ng + (c & 63) + 4);
    v4u ofn = {0u, 0u, 0u, 0u}, obn = ofn, zzn = ofn;
    if (gw < M / 2) { const bf16* pr = P + (size_t)(2 * gw + half) * D_IN; ofn = *(const v4u*)(pr + 1536 + c); obn = *(const v4u*)(pr + 1792 + c); zzn = *(const v4u*)(pr + 2304 + c); }
#pragma unroll 1
    for (int pk = gw; pk < M / 2; pk += NGW) {
        const v4u of = ofn, ob = obn, zz = zzn;
        { const int pn = pk + NGW < M / 2 ? pk + NGW : pk; const bf16* pr = P + (size_t)(2 * pn + half) * D_IN; ofn = *(const v4u*)(pr + 1536 + c); obn = *(const v4u*)(pr + 1792 + c); zzn = *(const v4u*)(pr + 2304 + c); }
        float o[8], z[8]; float ss = 0.f;
#pragma unroll
        for (int e = 0; e < 4; ++e) { o[2 * e] = bflo(of[e]) + bflo(ob[e]); o[2 * e + 1] = bfhi(of[e]) + bfhi(ob[e]); z[2 * e] = bflo(zz[e]); z[2 * e + 1] = bfhi(zz[e]);
            ss += o[2 * e] * o[2 * e] + o[2 * e + 1] * o[2 * e + 1]; }
        ss += __shfl_xor(ss, 1); ss += __shfl_xor(ss, 2); ss += __shfl_xor(ss, 4);
        const float r = 1.f / sqrtf(ss * (1.f / 64.f) + 1e-6f);
        v4u w;
#pragma unroll
        for (int e = 0; e < 4; ++e) { const float ga = e < 2 ? g0[2 * e] : g1[2 * e - 4], gb = e < 2 ? g0[2 * e + 1] : g1[2 * e - 3];
            const float ya = o[2 * e] * r * ga * (z[2 * e] / (1.f + __expf(-z[2 * e]))), yb = o[2 * e + 1] * r * gb * (z[2 * e + 1] / (1.f + __expf(-z[2 * e + 1])));
            w[e] = pk2(ya, yb); }
        *(v4u*)(mix + (size_t)(2 * pk + half) * D + 768 + c) = w;
    }
}

#ifndef MK_DEBUG
#define MK_DEBUG 0
#endif
#if MK_DEBUG
constexpr size_t WS_FLAG = WS_END;
__device__ __forceinline__ bool bad16(unsigned u) { return (u & 0x7f80u) >= (147u << 7); }
__device__ __forceinline__ bool bad32(unsigned u) { return (u & 0x7f800000u) >= (147u << 23); }
__global__ void __launch_bounds__(512) dbg_scan(const unsigned* buf, size_t nwords, int is16, unsigned* flag, int code) {
    bool bad = false;
    for (size_t i = (size_t)blockIdx.x * 512 + threadIdx.x; i < nwords; i += (size_t)gridDim.x * 512) { const unsigned u = buf[i]; bad |= is16 ? (bad16(u) || bad16(u >> 16)) : bad32(u); }
    if (bad) atomicMin(flag, (unsigned)code);
}
__global__ void __launch_bounds__(512) dbg_scan2(const unsigned short* buf, int rows, int ld, int c0, int nc, unsigned* flag, int code) {
    bool bad = false;
    for (size_t i = (size_t)blockIdx.x * 512 + threadIdx.x; i < (size_t)rows * nc; i += (size_t)gridDim.x * 512) { const size_t r = i / nc; const int c = (int)(i % nc); bad |= bad16(buf[r * ld + c0 + c]); }
    if (bad) atomicMin(flag, (unsigned)code);
}
__global__ void __launch_bounds__(512) dbg_fin(float* out, size_t n, const unsigned* flag) {
    const unsigned f = *flag; if (f == 0x7f7f7f7fu) return;
    const float v = sqrtf((float)(f + 1));
    for (size_t i = (size_t)blockIdx.x * 512 + threadIdx.x; i < n; i += (size_t)gridDim.x * 512) out[i] = v;
}
#endif
constexpr size_t WS_BAR = 1966080;
#define RLX_AGENT __ATOMIC_RELAXED, __HIP_MEMORY_SCOPE_AGENT
#define XB_TMO      128
#define XB_XCNT(j)  (256  + 64 * (j))
#define XB_XSUB(j)  (1280 + 64 * (j))
#define XB_XGEN(j)  (2304 + 64 * (j))
#define XB_TOP      3328
#define XB_TOPGEN   3392
#define XCD_BAR_WORDS 3456
#define XB_SPIN_CAP (1u << 18)

__device__ __forceinline__ unsigned xb_ld(unsigned* p)              { return __hip_atomic_load(p, __ATOMIC_RELAXED, __HIP_MEMORY_SCOPE_AGENT); }
__device__ __forceinline__ unsigned xb_add(unsigned* p, unsigned v) { return __hip_atomic_fetch_add(p, v, __ATOMIC_RELAXED, __HIP_MEMORY_SCOPE_AGENT); }
__device__ __forceinline__ unsigned xb_xcc_id() { return (unsigned)__builtin_amdgcn_s_getreg((3 << 11) | 20) & 0xFu; }
#define XB_SPIN(cond, bar) do { unsigned _sp = 0; while (cond) { __builtin_amdgcn_s_sleep(1); \
    if ((++_sp & 255u) == 0u) { if (xb_ld(&(bar)[XB_TMO])) break; if (_sp > XB_SPIN_CAP) { atomicAdd(&(bar)[XB_TMO], 1u); break; } } } } while (0)

struct XcdBarrier {
    unsigned* bar; unsigned x;
    volatile LAS unsigned* st;
};

__device__ __forceinline__ XcdBarrier xcd_barrier_post(unsigned* bar, volatile LAS unsigned* st) {
    XcdBarrier b; b.bar = bar; b.x = xb_xcc_id(); b.st = st;
    if (threadIdx.x == 0) (void)xb_add(&bar[XB_XCNT(b.x)], 1u);
    return b;
}
__device__ __forceinline__ void xcd_barrier_complete(unsigned* bar, unsigned x, unsigned& nloc, unsigned& nx) {
    const unsigned G = gridDim.x * gridDim.y * gridDim.z;
    unsigned sum, cnt, mine, sp = 0u;
    for (;;) {
        sum = 0u; cnt = 0u; mine = 0u;
#pragma unroll
        for (unsigned j = 0; j < 16; ++j) { const unsigned c = xb_ld(&bar[XB_XCNT(j)]); sum += c; cnt += (c > 0u) ? 1u : 0u; mine = (j == x) ? c : mine; }
        if (sum == G) break;
        __builtin_amdgcn_s_sleep(1);
        if ((++sp & 255u) == 0u) { if (xb_ld(&bar[XB_TMO])) break; if (sp > XB_SPIN_CAP) { atomicAdd(&bar[XB_TMO], 1u); break; } }
    }
    nloc = mine > 0u ? mine : 1u; nx = cnt > 0u ? cnt : 1u;
}

__device__ __forceinline__ void xcd_barrier(const XcdBarrier& b) {
    asm volatile("s_waitcnt vmcnt(0)" ::: "memory");
    __syncthreads();
    if (threadIdx.x == 0) {
        unsigned* bar = b.bar;
        __builtin_amdgcn_s_waitcnt(0);
        unsigned nloc = b.st[0], nx = b.st[1];
        if (nloc == 0u) { xcd_barrier_complete(bar, b.x, nloc, nx); b.st[0] = nloc; b.st[1] = nx; }
        const unsigned old = xb_add(&bar[XB_XSUB(b.x)], 1u);
        const unsigned gen = old / nloc;
        if (old + 1u == (gen + 1u) * nloc) {
            __builtin_amdgcn_fence(__ATOMIC_RELEASE, "agent");
            asm volatile("s_waitcnt vmcnt(0)" ::: "memory");
            const unsigned og = xb_add(&bar[XB_TOP], 1u);
            const unsigned tg = og / nx;
            if (og + 1u == (tg + 1u) * nx) xb_add(&bar[XB_TOPGEN], 1u);
            else XB_SPIN(xb_ld(&bar[XB_TOPGEN]) == tg, bar);
            __builtin_amdgcn_fence(__ATOMIC_ACQUIRE, "agent");
            xb_add(&bar[XB_XGEN(b.x)], 1u);
            asm volatile("s_waitcnt vmcnt(0)" ::: "memory");
        } else {
            XB_SPIN(xb_ld(&bar[XB_XGEN(b.x)]) == gen, bar);
            __builtin_amdgcn_fence(__ATOMIC_ACQUIRE, "agent");
            asm volatile("s_waitcnt vmcnt(0)" ::: "memory");
        }
    }
    __syncthreads();
}

__global__ void __launch_bounds__(NTHREADS, 2) mega(Args a) {
    extern __shared__ __attribute__((aligned(16))) unsigned char lds_raw[];
#ifndef MK_TQOFF
#define MK_TQOFF 0.5f
#endif
#ifndef MK_TIMEPH
#define MK_TIMEPH -1
#endif
#if MK_TIMEPH >= 0
    unsigned long long tacc = 0, tprev = __builtin_amdgcn_s_memrealtime();
#endif
    volatile LAS unsigned* xst = (volatile LAS unsigned*)((LAS unsigned char*)lds_raw + 147456);
    if (threadIdx.x < 2) xst[threadIdx.x] = 0u;
    __syncthreads();
    XcdBarrier xbar = xcd_barrier_post((unsigned*)(a.ws + WS_BAR), xst);
    for (int p = a.ph_lo; p < a.ph_hi; ++p) {
        int tid = threadIdx.x; asm volatile("" : "+v"(tid));
        int bid = blockIdx.x; asm volatile("" : "+s"(bid));
        int G = gridDim.x; asm volatile("" : "+s"(G));
        size_t zoff = 0; asm volatile("" : "+s"(zoff));
        unsigned char* ws = a.ws + zoff;
        float* X = a.out + zoff;
        unsigned ldsoff = 0; asm volatile("" : "+s"(ldsoff));
        LAS unsigned char* lds = (LAS unsigned char*)lds_raw + ldsoff;
        const int lane = tid & 63, wave = __builtin_amdgcn_readfirstlane(tid >> 6);
        const int gw = bid * 8 + wave, NGW = G * 8;
        bf16* XN = (bf16*)(ws + WS_XN); bf16* P = (bf16*)(ws + WS_P); bf16* H = (bf16*)(ws + WS_H);
        const float* modbuf = (const float*)(ws + WS_MOD); float* stats = (float*)(ws + WS_STATS);
        int l = 0, pp = p;
        if (p >= 2) { l = (p - 2) / 9; pp = 2 + (p - 2) % 9; }
        const float* modl = modbuf + (size_t)l * NBATCH * 6144;
#ifndef PHMASK
#define PHMASK 0xFFFF
#endif
#define PH_ON(k) (((PHMASK) >> (k)) & 1)
        switch (pp) {
        case 0: if (!PH_ON(0)) break; for (int cl = 0; cl < DEPTH; ++cl) convert_layer(a, ws, cl, lds, gw, NGW, wave, lane); __syncthreads(); mod_phase(a, ws, lds, tid, wave, lane, bid, G); break;
        case 1: if (!PH_ON(1)) break; ln_rows(a.in[0], a.in[1], true, X, a.in[4], a.in[5], modbuf, 0, XN, stats, gw, NGW, lane); break;
        case 2: if (!PH_ON(2)) break; { pg8::Gemm g{XN, (const bf16*)(ws + WS_WIN + wbase(l)), M, D_INP, D}; pg8::StaticOrder S; S.init(M, D_INP, G, bid); pg8::EpiP E{P};
                  pg8::gemm_phase<pg8::EpiP, pg8::StaticOrder, true, true>(lds, g, S, E, tid); } break;
        case 3: if (!PH_ON(3)) break; dn_prep(a, ws, l, lds, tid, wave, lane, bid, G); break;
        case 4: if (!PH_ON(4)) break; if (bid < NSCAN) { if (PH_ON(11)) dn_scan_block(ws, bid, lds, wave, lane); }
                else if (PH_ON(12)) { const int na = G - NSCAN, ab = bid - NSCAN;
                    const int vb = ((na & 7) == 0 && (NSCAN & 7) == 0) ? (ab & 7) * (na >> 3) + (ab >> 3) : ab;
#pragma unroll 1
                    for (int u = vb; u < 1280; u += na) attn_unit(P, XN, a.in[10] + l * 8, u, lds, tid, wave, lane);
                    conv_items(P, XN, a.in[9] + (size_t)l * 768, ab * NTHREADS + tid, na * NTHREADS); }
                break;
        case 5: if (!PH_ON(5)) break; dn_post(P, XN, a.in[16] + l * 64, gw, NGW, lane); break;
        case 6: if (!PH_ON(6)) break; { pg8::Gemm g{XN, (const bf16*)(ws + WS_WOUT + wbase(l)), M, D, D}; pg8::StaticOrder S; S.init(M, D, G, bid); pg8::EpiRes E{X, modl + 2048, nullptr, stats, l > 0 ? a.in[24] + (l - 1) * D : a.in[4], l > 0 ? a.in[25] + (l - 1) * D : a.in[5], l > 0 ? nullptr : a.in[0], l > 0 ? nullptr : a.in[1]};
                  pg8::gemm_phase<pg8::EpiRes, pg8::StaticOrder, true, true>(lds, g, S, E, tid); } break;
        case 7: if (!PH_ON(7)) break; ln_rows(nullptr, nullptr, false, X, a.in[18] + l * D, a.in[19] + l * D, modl, 3072, XN, stats, gw, NGW, lane); break;
        case 8: if (!PH_ON(8)) break; { pg8::Gemm g{XN, (const bf16*)(ws + WS_W1 + wbase(l)), M, D_FF, D}; pg8::StaticOrder S; S.init(M, D_FF, G, bid); pg8::EpiH E{H, a.in[21] + (size_t)l * D_FF};
                  pg8::gemm_phase<pg8::EpiH, pg8::StaticOrder, true, true>(lds, g, S, E, tid); } break;
        case 9: if (!PH_ON(9)) break; { pg8::Gemm g{H, (const bf16*)(ws + WS_W2 + wbase(l)), M, D, D_FF}; pg8::StaticOrder S; S.init(M, D, G, bid); pg8::EpiRes E{X, modl + 5120, a.in[23] + (size_t)l * D, stats, a.in[18] + l * D, a.in[19] + l * D, nullptr, nullptr};
                  pg8::gemm_phase<pg8::EpiRes, pg8::StaticOrder, true, true>(lds, g, S, E, tid); } break;
        case 10: if (!PH_ON(10)) break; if (l < DEPTH - 1) { ln_rows(nullptr, nullptr, false, X, a.in[24] + l * D, a.in[25] + l * D, modl + (size_t)NBATCH * 6144, 0, XN, stats, gw, NGW, lane); }
                 else ln_rows(nullptr, nullptr, false, X, a.in[24] + l * D, a.in[25] + l * D, nullptr, 0, nullptr, nullptr, gw, NGW, lane);
                 break;
        }
#if MK_TIMEPH >= 0
        { const unsigned long long t0 = __builtin_amdgcn_s_memrealtime();
          cg::this_grid().sync();
          const unsigned long long t1 = __builtin_amdgcn_s_memrealtime();
          if (MK_TIMEPH == 100 || pp == MK_TIMEPH) tacc += t1 - tprev; else if (MK_TIMEPH == 200 + pp) tacc += t1 - t0;
          tprev = t1; }
#else
        if (p + 1 < a.ph_hi) { if (p == a.ph_lo) cg::this_grid().sync(); else xcd_barrier(xbar); }
#endif
    }
#if MK_TIMEPH >= 0
    { unsigned* tw = (unsigned*)(a.ws + WS_END);
      if (blockIdx.x == 0 && threadIdx.x == 0) __hip_atomic_store(tw, (unsigned)(tacc / 100), __ATOMIC_RELAXED, __HIP_MEMORY_SCOPE_AGENT);
      cg::this_grid().sync();
      const float tq = floorf(__logf(fmaxf((float)__hip_atomic_load(tw, __ATOMIC_RELAXED, __HIP_MEMORY_SCOPE_AGENT), 1.f)) * (1.f / 0.4054651f) + MK_TQOFF); const float v = sqrtf(__expf((tq - MK_TQOFF + 0.5f) * 0.4054651f));
      for (size_t i = (size_t)blockIdx.x * NTHREADS + threadIdx.x; i < (size_t)M * D; i += (size_t)gridDim.x * NTHREADS) a.out[i] = v; }
#endif
}
constexpr int NPHASES = 2 + 9 * DEPTH;

extern "C" void kernel_launch(void* const* d_in, const int* in_sizes, int n_in, void* d_out, int out_size, void* d_ws, size_t ws_size, hipStream_t stream) {
    static int grid = 0;
    if (grid == 0) {
        if (n_in != 26 || out_size != M * D || ws_size < 1024 * MiB) { fprintf(stderr, "kernel_launch: unexpected sizes n_in %d out %d ws %zu\n", n_in, out_size, ws_size); grid = -1; return; }
        int dev = 0, cus = 0, per_cu = 0;
        hipGetDevice(&dev); hipDeviceGetAttribute(&cus, hipDeviceAttributeMultiprocessorCount, dev);
        if (hipFuncSetAttribute((const void*)mega, hipFuncAttributeMaxDynamicSharedMemorySize, LDS_BYTES) != hipSuccess) { fprintf(stderr, "kernel_launch: hipFuncSetAttribute failed\n"); grid = -1; return; }
        if (hipOccupancyMaxActiveBlocksPerMultiprocessor(&per_cu, (const void*)mega, NTHREADS, LDS_BYTES) != hipSuccess || per_cu < 1) { fprintf(stderr, "kernel_launch: occupancy query says %d\n", per_cu); per_cu = 1; }
        (void)hipGetLastError();
        grid = cus * 1;
        if (grid <= NSCAN + 8) { fprintf(stderr, "kernel_launch: grid %d too small\n", grid); grid = -1; return; }
    }
    if (grid < 0) return;
    Args a{};
    for (int i = 0; i < 26; ++i) a.in[i] = (const float*)d_in[i];
    a.out = (float*)d_out; a.ws = (unsigned char*)d_ws;
#if MK_MULTI
#if MK_DEBUG
    unsigned* flag = (unsigned*)((unsigned char*)d_ws + WS_FLAG);
    (void)hipMemsetAsync(flag, 0x7f, 4, stream);
    unsigned char* wsb = (unsigned char*)d_ws;
#define DSCAN(off, bytes, is16, code) hipLaunchKernelGGL(dbg_scan, dim3(1024), dim3(512), 0, stream, (const unsigned*)(wsb + (off)), (size_t)(bytes) / 4, is16, flag, code)
#define DSCANX(code) hipLaunchKernelGGL(dbg_scan, dim3(1024), dim3(512), 0, stream, (const unsigned*)d_out, (size_t)M * D, 0, flag, code)
#endif
    for (int p = 0; p < NPHASES; ++p) { a.ph_lo = p; a.ph_hi = p + 1; hipLaunchKernelGGL(mega, dim3(grid), dim3(NTHREADS), LDS_BYTES, stream, a);
#if MK_DEBUG
        const int pp = p < 2 ? p : 2 + (p - 2) % 9;
        const int code = p * 4;
        switch (pp) {
        case 0: DSCAN(WS_MOD, DEPTH * NBATCH * 6144 * 4, 0, code); DSCAN(WS_WIN, WS_P - WS_WIN - MiB / 2, 1, code + 1); break;
        case 1: case 7: case 10: DSCANX(code); DSCAN(WS_XN, (size_t)M * D * 2, 1, code + 1); break;
        case 2: DSCAN(WS_P, (size_t)M * D_IN * 2, 1, code); break;
        case 3: DSCAN(WS_DNC, 320 * MiB, 1, code); DSCAN(WS_QH, 40 * MiB, 1, code + 3); break;
        case 4: hipLaunchKernelGGL(dbg_scan2, dim3(1024), dim3(512), 0, stream, (const unsigned short*)(wsb + WS_XN), M, D, 0, 256, flag, code);
                hipLaunchKernelGGL(dbg_scan2, dim3(1024), dim3(512), 0, stream, (const unsigned short*)(wsb + WS_XN), M, D, 256, 512, flag, code + 1);
                hipLaunchKernelGGL(dbg_scan2, dim3(1024), dim3(512), 0, stream, (const unsigned short*)(wsb + WS_P), M, D_IN, 1536, 512, flag, code + 2);
                hipLaunchKernelGGL(dbg_scan2, dim3(1024), dim3(512), 0, stream, (const unsigned short*)(wsb + WS_XN), M, D, 768, 256, flag, code + 3); break;
        case 5: DSCAN(WS_XN, (size_t)M * D * 2, 1, code); break;
        case 6: case 9: DSCANX(code); break;
        case 8: DSCAN(WS_H, (size_t)M * D_FF * 2, 1, code); break;
        }
#endif
    }
#if MK_DEBUG
    hipLaunchKernelGGL(dbg_fin, dim3(1024), dim3(512), 0, stream, (float*)d_out, (size_t)M * D, flag);
#endif
#else
    a.ph_lo = 0; a.ph_hi = NPHASES;
    (void)hipMemsetAsync((unsigned char*)d_ws + WS_BAR, 0, 16384, stream);
    void* args[] = {&a};
    hipError_t e = hipLaunchCooperativeKernel((const void*)mega, dim3(grid), dim3(NTHREADS), args, LDS_BYTES, stream);
    if (e != hipSuccess) fprintf(stderr, "cooperative launch failed: %s (grid %d)\n", hipGetErrorString(e), grid);
#endif
}
```

```cpp
#include <hip/hip_runtime.h>
#include <hip/hip_cooperative_groups.h>
#include <cstdio>
#include <cstdint>
namespace cg = cooperative_groups;

#ifndef MK_MULTI
#define MK_MULTI 0
#endif

constexpr int D = 1024, DEPTH = 4;
constexpr int M_P = 4 * 4096, M_S = 8 * 8192, M = M_P + M_S;
constexpr int NBATCH = 12;
constexpr int D_IN = 2576, D_INP = 2816, D_FF = 4096;
constexpr int NCHUNK = M / 64;
constexpr float ALPHA = 1.681792830507429f;
__host__ __device__ __forceinline__ int batch_of_row(int m) { return m < M_P ? (m >> 12) : 4 + ((m - M_P) >> 13); }
__host__ __device__ __forceinline__ void batch_info(int b, int& row0, int& S) { if (b < 4) { row0 = b << 12; S = 4096; } else { row0 = M_P + ((b - 4) << 13); S = 8192; } }
namespace pg8 {
#define PG8_LAS __attribute__((address_space(3)))
typedef unsigned short bf16_t;
typedef short bf16x8 __attribute__((ext_vector_type(8)));
typedef float f32x4 __attribute__((ext_vector_type(4)));
typedef unsigned u32x4 __attribute__((ext_vector_type(4)));
constexpr int BM = 256, BK = 64, HALF = 128, HTB = HALF * BK * 2  , STAGE_BYTES = 8 * HTB, NXCD = 8, WGM = 8;

__host__ __device__ __forceinline__ int lds_byte(int r, int c) { const int st = (r >> 4) * 2 + (c >> 5), rr = r & 15, cc = c & 31, ob = rr * 64 + cc * 2; return st * 1024 + (ob ^ (((ob >> 9) & 1) << 5)); }
__host__ __device__ __forceinline__ void stage_rc(int b, int& R, int& C) { const int st = b / 1024, sb = b % 1024, swz = sb ^ (((sb >> 9) & 1) << 5); R = (st >> 1) * 16 + swz / 64; C = (st & 1) * 32 + (swz % 64) / 2; }
__host__ __device__ __forceinline__ int perm32(int rho) { const int n = rho >> 4, i = rho & 15; return 8 * (i >> 2) + 4 * n + (i & 3); }

struct Unit { int pm, pn; };
struct Gemm { const bf16_t* A; const bf16_t* Bt; int M, N, K; };

struct StaticOrder {
    int nM, nN, nwg, G, c;
    __host__ __device__ void init(int M, int N, int G_, int c_) { nM = M / BM; nN = N / BM; nwg = nM * nN; G = G_; c = c_; }
    __host__ __device__ bool next(int i, Unit& u) const {
        const long L = (long)i * G + c; if (L >= nwg) return false;
        int wgid = (int)L; { const int q = nwg / NXCD, r = nwg % NXCD, xcd = wgid % NXCD, off = wgid / NXCD; wgid = (xcd < r ? xcd * (q + 1) : r * (q + 1) + (xcd - r) * q) + off; }
        const int nig = WGM * nN, gid = wgid / nig, fm = gid * WGM, gsz = (nM - fm) < WGM ? (nM - fm) : WGM;
        u.pm = fm + ((wgid % nig) % gsz); u.pn = (wgid % nig) / gsz; return true;
    }
    __device__ __forceinline__ void a_ready(const Unit&) const {}
    __device__ __forceinline__ void done(const Unit&) const {}
};

typedef __bf16 bf16x2_t __attribute__((ext_vector_type(2)));
typedef float f32x2_t __attribute__((ext_vector_type(2)));
__device__ __forceinline__ unsigned cvt_pk_bf16(float lo, float hi) { const f32x2_t v = {lo, hi}; const bf16x2_t b = __builtin_convertvector(v, bf16x2_t); return __builtin_bit_cast(unsigned, b); }
typedef float f32x2 __attribute__((ext_vector_type(2)));
struct EpiP {
    static constexpr bool PERM = true, AFTER_DRAIN = false;
    bf16_t* O;
    __device__ __forceinline__ void operator()(const f32x4 (&acc)[2][2][4][2], const Unit& u, int wr, int wc, int fr, int fq) const {
        const int row0 = u.pm * BM + wr * 64 + fr; const int col0 = u.pn * BM + wc * 32 + 8 * fq;
#pragma unroll
        for (int ai = 0; ai < 2; ++ai)
#pragma unroll
            for (int m = 0; m < 4; ++m) { bf16_t* rowp = O + (size_t)(row0 + ai * HALF + m * 16) * 2576 + col0;
#pragma unroll
                for (int bj = 0; bj < 2; ++bj) { if (col0 + bj * HALF < 2576) { const f32x4 v0 = acc[ai][bj][m][0], v1 = acc[ai][bj][m][1];
                    u32x4 w; w.x = cvt_pk_bf16(v0[0], v0[1]); w.y = cvt_pk_bf16(v0[2], v0[3]); w.z = cvt_pk_bf16(v1[0], v1[1]); w.w = cvt_pk_bf16(v1[2], v1[3]);
                    *(u32x4*)(rowp + bj * HALF) = w; } } }
    }
};
struct EpiH {
    static constexpr bool PERM = true, AFTER_DRAIN = false;
    bf16_t* O; const float* bias;
    __device__ __forceinline__ void operator()(const f32x4 (&acc)[2][2][4][2], const Unit& u, int wr, int wc, int fr, int fq) const {
        const int row0 = u.pm * BM + wr * 64 + fr; const int col0 = u.pn * BM + wc * 32 + 8 * fq;
        f32x4 bv[2][2];
#pragma unroll
        for (int bj = 0; bj < 2; ++bj)
#pragma unroll
            for (int n = 0; n < 2; ++n) bv[bj][n] = *(const f32x4*)(bias + col0 + bj * HALF + 4 * n);
#pragma unroll
        for (int ai = 0; ai < 2; ++ai)
#pragma unroll
            for (int m = 0; m < 4; ++m) { bf16_t* rowp = O + (size_t)(row0 + ai * HALF + m * 16) * 4096 + col0;
#pragma unroll
                for (int bj = 0; bj < 2; ++bj) { f32x4 v0 = acc[ai][bj][m][0] + bv[bj][0], v1 = acc[ai][bj][m][1] + bv[bj][1];
                    v0 = __builtin_elementwise_max(v0, (f32x4){0.f, 0.f, 0.f, 0.f}); v1 = __builtin_elementwise_max(v1, (f32x4){0.f, 0.f, 0.f, 0.f}); v0 = v0 * v0; v1 = v1 * v1;
                    u32x4 w; w.x = cvt_pk_bf16(v0[0], v0[1]); w.y = cvt_pk_bf16(v0[2], v0[3]); w.z = cvt_pk_bf16(v1[0], v1[1]); w.w = cvt_pk_bf16(v1[2], v1[3]);
                    *(u32x4*)(rowp + bj * HALF) = w; } }
    }
};
struct EpiRes {
    static constexpr bool PERM = false, AFTER_DRAIN = false;
    float* X; const float* gate  ; const float* bias  ;
    const float* stats  ; const float* gam; const float* bet;
    const float* src_p; const float* src_s;
    __device__ __forceinline__ void operator()(const f32x4 (&acc)[2][2][4][2], const Unit& u, int wr, int wc, int fr, int fq) const {
        const int row0 = u.pm * BM + wr * 64 + fr; const int col0 = u.pn * BM + wc * 32 + 4 * fq;
        const float* gb = gate + (size_t)batch_of_row(u.pm * BM) * 6144;
        const float* XS = src_p ? (u.pm * BM < M_P ? src_p : src_s - (size_t)M_P * 1024) : X;
#pragma unroll
        for (int bj = 0; bj < 2; ++bj) {
            f32x4 av[2], gv[2], cv[2];
#pragma unroll
            for (int n = 0; n < 2; ++n) { const int c = col0 + bj * HALF + n * 16;
                gv[n] = *(const f32x4*)(gb + c) + 1.0f;
                const f32x4 bv = bias ? *(const f32x4*)(bias + c) : (f32x4){0.f, 0.f, 0.f, 0.f};
                if (stats) { av[n] = *(const f32x4*)(gam + c) * ALPHA; cv[n] = *(const f32x4*)(bet + c) * ALPHA + gv[n] * bv; }
                else { av[n] = (f32x4){ALPHA, ALPHA, ALPHA, ALPHA}; cv[n] = gv[n] * bv; } }
#pragma unroll
            for (int ai = 0; ai < 2; ++ai)
#pragma unroll
                for (int mp = 0; mp < 2; ++mp) {
                    f32x4 xo[2][2]; f32x2 st[2];
#pragma unroll
                    for (int mm = 0; mm < 2; ++mm) { const int r = row0 + ai * HALF + (2 * mp + mm) * 16; const float* xp = XS + (size_t)r * 1024 + col0 + bj * HALF;
                        xo[mm][0] = *(const f32x4*)xp; xo[mm][1] = *(const f32x4*)(xp + 16);
                        st[mm] = stats ? *(const f32x2*)(stats + 2 * (size_t)r) : (f32x2){0.f, 1.f}; }
#pragma unroll
                    for (int mm = 0; mm < 2; ++mm) { const int m = 2 * mp + mm; const int r = row0 + ai * HALF + m * 16; float* xp = X + (size_t)r * 1024 + col0 + bj * HALF;
#pragma unroll
                        for (int n = 0; n < 2; ++n)
                            *(f32x4*)(xp + n * 16) = ((xo[mm][n] - st[mm].x) * st[mm].y) * av[n] + gv[n] * acc[ai][bj][m][n] + cv[n]; }
                    asm volatile("" ::: "memory");
                }
        }
    }
};
template <class Epi, class Sched, bool ALIGN_EPI = false, bool SP2 = false>
__device__ __forceinline__ void gemm_phase(PG8_LAS unsigned char* lds, const Gemm g, const Sched& S, const Epi& E, const int tid) {
    const int wid = __builtin_amdgcn_readfirstlane(tid >> 6), lane = tid & 63, wr = wid >> 2, wc = wid & 3, fr = lane & 15, fq = lane >> 4;
    const int K = g.K, nt = K / BK;
    unsigned voffA[2], voffB[2];
#pragma unroll
    for (int i = 0; i < 2; ++i) { int R, C; stage_rc(tid * 16 + i * 8192, R, C); const int Rb = Epi::PERM ? ((R & ~31) + perm32(R & 31)) : R;
        voffA[i] = (unsigned)(R * K + C) * 2u; voffB[i] = (unsigned)(Rb * K + C) * 2u; }
    const size_t kstep = (size_t)(BK * 2);
    const size_t hstep = (size_t)HALF * K * 2;
    const size_t tstep = 2 * hstep;
    const unsigned ldsw = (unsigned)wid * 1024u;
    const int aoff = lds_byte(wr * 64 + fr, fq * 8), boff = lds_byte(wc * 32 + fr, fq * 8);
#define PG8_SA(b, h) (((b) * 2 + (h)) * HTB)
#define PG8_SB(b, h) ((4 + (b) * 2 + (h)) * HTB)
#define PG8_STAGE(bufoff, gbase, voff) do { _Pragma("unroll") for (int _i = 0; _i < 2; ++_i) \
        __builtin_amdgcn_global_load_lds((const unsigned*)((const char*)(gbase) + (voff)[_i]), (PG8_LAS unsigned*)(lds + (bufoff) + ldsw + _i * 8192), 16, 0, 0); } while (0)
#define PG8_LDA(dst, b, h) do { _Pragma("unroll") for (int m = 0; m < 4; ++m) _Pragma("unroll") for (int k = 0; k < 2; ++k) dst[m][k] = *(const PG8_LAS bf16x8*)(lds + PG8_SA(b, h) + aoff + m * 2048 + k * 1024); } while (0)
#define PG8_LDB(dst, b, h) do { _Pragma("unroll") for (int n = 0; n < 2; ++n) _Pragma("unroll") for (int k = 0; k < 2; ++k) dst[n][k] = *(const PG8_LAS bf16x8*)(lds + PG8_SB(b, h) + boff + n * 2048 + k * 1024); } while (0)
#define PG8_MMA(ai, bj, At, Bt) do { __builtin_amdgcn_s_setprio(1); _Pragma("unroll") for (int m = 0; m < 4; ++m) _Pragma("unroll") for (int n = 0; n < 2; ++n) _Pragma("unroll") for (int k = 0; k < 2; ++k) \
        acc[ai][bj][m][n] = __builtin_amdgcn_mfma_f32_16x16x32_bf16(Bt[n][k], At[m][k], acc[ai][bj][m][n], 0, 0, 0); __builtin_amdgcn_s_setprio(0); } while (0)
#define PG8_WAIT_V(n) asm volatile("s_waitcnt vmcnt(" #n ")" ::: "memory")
#define PG8_WAIT_L(n) asm volatile("s_waitcnt lgkmcnt(" #n ")" ::: "memory")
#define PG8_BAR __builtin_amdgcn_s_barrier()
#define PG8_SCHED __builtin_amdgcn_sched_barrier(0)
    Unit cur, nxt; int ui = 0;
    if (!S.next(0, cur)) return;
    f32x4 acc[2][2][4][2];
#pragma unroll
    for (int a = 0; a < 2; ++a)
#pragma unroll
        for (int b = 0; b < 2; ++b)
#pragma unroll
            for (int m = 0; m < 4; ++m)
#pragma unroll
                for (int n = 0; n < 2; ++n) acc[a][b][m][n] = (f32x4){0.f, 0.f, 0.f, 0.f};
    bf16x8 At[4][2], B0[2][2], B1[2][2];
    const char* cA = (const char*)g.A + (size_t)cur.pm * tstep; const char* cB = (const char*)g.Bt + (size_t)cur.pn * tstep;
    S.a_ready(cur);
    if constexpr (SP2) {
        PG8_STAGE(PG8_SB(0, 0), cB, voffB); PG8_STAGE(PG8_SB(0, 1), cB + hstep, voffB); PG8_STAGE(PG8_SA(0, 0), cA, voffA); PG8_STAGE(PG8_SA(0, 1), cA + hstep, voffA);
        if (wr == 1) PG8_BAR;
        PG8_WAIT_V(2); PG8_BAR;
        PG8_STAGE(PG8_SB(1, 0), cB + kstep, voffB); PG8_STAGE(PG8_SA(1, 0), cA + kstep, voffA); PG8_STAGE(PG8_SB(1, 1), cB + hstep + kstep, voffB);
        PG8_WAIT_V(6); PG8_BAR;
    } else {
        PG8_STAGE(PG8_SB(0, 0), cB, voffB); PG8_STAGE(PG8_SA(0, 0), cA, voffA); PG8_STAGE(PG8_SB(0, 1), cB + hstep, voffB); PG8_STAGE(PG8_SA(0, 1), cA + hstep, voffA);
        if (wr == 1) PG8_BAR;
        PG8_WAIT_V(4); PG8_BAR;
        PG8_STAGE(PG8_SB(1, 0), cB + kstep, voffB); PG8_STAGE(PG8_SA(1, 0), cA + kstep, voffA); PG8_STAGE(PG8_SB(1, 1), cB + hstep + kstep, voffB);
        PG8_WAIT_V(6); PG8_BAR;
    }
    for (;;) {
        const bool has_next = S.next(ui + 1, nxt);
        const char* nA = has_next ? (const char*)g.A + (size_t)nxt.pm * tstep : cA; const char* nB = has_next ? (const char*)g.Bt + (size_t)nxt.pn * tstep : cB;
        for (int t = 0; t < nt; t += 2) {
            const bool last = (t == nt - 2);
            const char* a1 = cA + (size_t)(t + 1) * kstep;
            const char* a2 = last ? nA : cA + (size_t)(t + 2) * kstep; const char* b2 = last ? nB : cB + (size_t)(t + 2) * kstep;
            const char* a3 = a2 + kstep; const char* b3 = b2 + kstep;
            if (last && has_next) S.a_ready(nxt);
            if constexpr (SP2) {
            PG8_LDB(B0, 0, 0); PG8_LDB(B1, 0, 1); PG8_SCHED; PG8_LDA(At, 0, 0); PG8_STAGE(PG8_SA(1, 1), a1 + hstep, voffA);
            PG8_WAIT_V(8); PG8_WAIT_L(0); PG8_BAR; PG8_MMA(0, 0, At, B0); PG8_MMA(0, 1, At, B1); PG8_BAR; PG8_SCHED;
            PG8_LDA(At, 0, 1); PG8_STAGE(PG8_SB(0, 0), b2, voffB); PG8_STAGE(PG8_SB(0, 1), b2 + hstep, voffB); PG8_STAGE(PG8_SA(0, 0), a2, voffA);
            PG8_WAIT_V(8); PG8_WAIT_L(0); PG8_BAR; PG8_MMA(1, 0, At, B0); PG8_MMA(1, 1, At, B1); PG8_BAR; PG8_SCHED;
            PG8_LDB(B0, 1, 0); PG8_LDB(B1, 1, 1); PG8_SCHED; PG8_LDA(At, 1, 0); PG8_STAGE(PG8_SA(0, 1), a2 + hstep, voffA);
            PG8_WAIT_V(8); PG8_WAIT_L(0); PG8_BAR; PG8_MMA(0, 0, At, B0); PG8_MMA(0, 1, At, B1); PG8_BAR; PG8_SCHED;
            PG8_LDA(At, 1, 1); PG8_STAGE(PG8_SB(1, 0), b3, voffB); PG8_STAGE(PG8_SB(1, 1), b3 + hstep, voffB); PG8_STAGE(PG8_SA(1, 0), a3, voffA);
            PG8_WAIT_V(8); PG8_WAIT_L(0); PG8_BAR; PG8_MMA(1, 0, At, B0); PG8_MMA(1, 1, At, B1); PG8_BAR; PG8_SCHED;
            } else {
            PG8_LDB(B0, 0, 0); PG8_SCHED; PG8_LDA(At, 0, 0); PG8_STAGE(PG8_SA(1, 1), a1 + hstep, voffA);
            PG8_WAIT_L(8); PG8_BAR; PG8_WAIT_L(0); PG8_MMA(0, 0, At, B0); PG8_BAR; PG8_SCHED;
            PG8_LDB(B1, 0, 1); PG8_STAGE(PG8_SB(0, 0), b2, voffB);
            PG8_BAR; PG8_WAIT_L(0); PG8_MMA(0, 1, At, B1); PG8_BAR;
            PG8_LDA(At, 0, 1); PG8_STAGE(PG8_SA(0, 0), a2, voffA);
            PG8_BAR; PG8_WAIT_L(0); PG8_MMA(1, 0, At, B0); PG8_BAR; PG8_SCHED;
            PG8_STAGE(PG8_SB(0, 1), b2 + hstep, voffB);
            PG8_WAIT_V(6); PG8_BAR; PG8_MMA(1, 1, At, B1); PG8_BAR;
            PG8_LDB(B0, 1, 0); PG8_SCHED; PG8_LDA(At, 1, 0); PG8_STAGE(PG8_SA(0, 1), a2 + hstep, voffA);
            PG8_WAIT_L(8); PG8_BAR; PG8_WAIT_L(0); PG8_MMA(0, 0, At, B0); PG8_BAR; PG8_SCHED;
            PG8_LDB(B1, 1, 1); PG8_STAGE(PG8_SB(1, 0), b3, voffB);
            PG8_BAR; PG8_WAIT_L(0); PG8_MMA(0, 1, At, B1); PG8_BAR;
            PG8_LDA(At, 1, 1); PG8_STAGE(PG8_SA(1, 0), a3, voffA);
            PG8_BAR; PG8_WAIT_L(0); PG8_MMA(1, 0, At, B0); PG8_BAR; PG8_SCHED;
            PG8_STAGE(PG8_SB(1, 1), b3 + hstep, voffB);
            PG8_WAIT_V(6); PG8_BAR; PG8_MMA(1, 1, At, B1); PG8_BAR;
            }
        }
        if constexpr (ALIGN_EPI) { if (wr == 0) PG8_BAR; }
        if constexpr (!Epi::AFTER_DRAIN) { E(acc, cur, wr, wc, fr, fq); S.done(cur); }
        if (!has_next) break;
#pragma unroll
        for (int a = 0; a < 2; ++a)
#pragma unroll
            for (int b = 0; b < 2; ++b)
#pragma unroll
                for (int m = 0; m < 4; ++m)
#pragma unroll
                    for (int n = 0; n < 2; ++n) acc[a][b][m][n] = (f32x4){0.f, 0.f, 0.f, 0.f};
        cur = nxt; cA = nA; cB = nB; ++ui;
        if constexpr (ALIGN_EPI) { if (wr == 1) PG8_BAR; }
    }
    PG8_WAIT_V(0);
    if constexpr (!ALIGN_EPI) { if (wr == 0) PG8_BAR; }
    PG8_BAR;
    if constexpr (Epi::AFTER_DRAIN) { E.fused(acc, cur, wr, wc, fr, fq, lds, wid, lane); S.done(cur); }
#undef PG8_SA
#undef PG8_SB
#undef PG8_STAGE
#undef PG8_LDA
#undef PG8_LDB
#undef PG8_MMA
#undef PG8_WAIT_V
#undef PG8_WAIT_L
#undef PG8_BAR
#undef PG8_SCHED
}
}

#define GAS __attribute__((address_space(1)))
#define LAS __attribute__((address_space(3)))
typedef unsigned short bf16;
typedef unsigned v4u __attribute__((ext_vector_type(4)));
typedef unsigned v2u __attribute__((ext_vector_type(2)));
typedef float f32x4 __attribute__((ext_vector_type(4)));
typedef short bf16x8 __attribute__((ext_vector_type(8)));
constexpr int NTHREADS = 512;
constexpr int LDS_BYTES = 147456 + 64;
constexpr int NSCAN = 96;

constexpr size_t MiB = 1u << 20;
constexpr size_t WS_MOD = 0;
constexpr size_t WS_EGL = WS_MOD + (size_t)DEPTH * NBATCH * 6144 * 4;
constexpr size_t WS_STATS = 1310720;
constexpr size_t WS_WIN = 2 * MiB, WS_WOUT = WS_WIN + (size_t)D_INP * D * 2, WS_W1 = WS_WOUT + (size_t)D * D * 2, WS_W2 = WS_W1 + (size_t)D_FF * D * 2;
constexpr size_t WS_P = 26 * MiB;
constexpr size_t WS_H = 26 * MiB;
constexpr size_t WS_DNC = 429 * MiB;
constexpr size_t WS_QH = 749 * MiB, WS_EG = 789 * MiB;
constexpr size_t WS_WX = 792 * MiB;
constexpr size_t WS_END = 863 * MiB;
constexpr size_t WS_XN = 864 * MiB;
static_assert(WS_W2 + (size_t)D * D_FF * 2 <= WS_P && WS_P + (size_t)M * D_IN * 2 <= WS_DNC && WS_DNC + (size_t)NCHUNK * 8 * 32768 <= WS_QH && WS_EG + (size_t)NCHUNK * 8 * 64 * 4 <= WS_END && WS_H + (size_t)M * D_FF * 2 <= WS_XN && WS_XN + (size_t)M * D * 2 <= 1024 * MiB && WS_EGL + NCHUNK * 8 * 4 <= WS_STATS && WS_STATS + (size_t)M * 8 <= 1966080 && 1966080 + 16384 <= WS_WIN && WS_END + 64 <= WS_XN, "ws map");

__device__ __forceinline__ float bflo(unsigned u) { return __builtin_bit_cast(float, u << 16); }
__device__ __forceinline__ float bfhi(unsigned u) { return __builtin_bit_cast(float, u & 0xffff0000u); }
__device__ __forceinline__ float bf1(bf16 u) { return __builtin_bit_cast(float, (unsigned)u << 16); }
__device__ __forceinline__ unsigned pk2(float lo, float hi) { return pg8::cvt_pk_bf16(lo, hi); }
__device__ __forceinline__ bf16 f2bf(float v) { return __builtin_bit_cast(unsigned short, (__bf16)v); }
__device__ __forceinline__ float wave_sum(float v) {
#pragma unroll
    for (int o = 1; o < 64; o <<= 1) v += __shfl_xor(v, o);
    return v;
}
constexpr size_t LAYER_W_BYTES = (size_t)D_INP * D * 2 + (size_t)D * D * 2 + 2 * (size_t)D_FF * D * 2;
static_assert(WS_WX + 3 * LAYER_W_BYTES <= WS_END, "ws map (weights)");
__host__ __device__ __forceinline__ size_t wbase(int l) { return l == 0 ? 0 : (WS_WX - WS_WIN) + (size_t)(l - 1) * LAYER_W_BYTES; }
__device__ __forceinline__ int dmap(int p) { return 16 * ((p >> 2) & 1) + 4 * (p >> 3) + (p & 3); }
__device__ __forceinline__ int ppos(int d) { return 8 * ((d >> 2) & 3) + 4 * (d >> 4) + (d & 3); }
#define MFMA_BF16(a, b, c) __builtin_amdgcn_mfma_f32_16x16x32_bf16((a), (b), (c), 0, 0, 0)

struct Args { const float* in[26]; float* out; unsigned char* ws; int ph_lo, ph_hi; };

__device__ __forceinline__ void transpose_item(const float* W, int K, int N, bf16* WT, LAS float* scr, int item, int nblk, int lane) {
    const int kb = item / nblk, nb = item % nblk, k0 = 64 * kb, n0 = 32 * nb;
    const int nn = n0 + (lane & 31);
#pragma unroll 8
    for (int i = 0; i < 32; ++i) { const int kk = 2 * i + (lane >> 5); scr[kk * 33 + (lane & 31)] = nn < N ? W[(size_t)(k0 + kk) * N + nn] : 0.f; }
    asm volatile("s_waitcnt lgkmcnt(0)" ::: "memory");
    const int c = lane & 7;
#pragma unroll
    for (int j = 0; j < 4; ++j) { const int n = (lane >> 3) + 8 * j; const LAS float* s = scr + (8 * c) * 33 + n;
        v4u o; o.x = pk2(s[0 * 33], s[1 * 33]); o.y = pk2(s[2 * 33], s[3 * 33]); o.z = pk2(s[4 * 33], s[5 * 33]); o.w = pk2(s[6 * 33], s[7 * 33]);
        *(v4u*)(WT + (size_t)(n0 + n) * K + k0 + 8 * c) = o; }
    asm volatile("s_waitcnt lgkmcnt(0)" ::: "memory");
}
__device__ __forceinline__ void convert_layer(const Args& a, unsigned char* ws, int l, LAS unsigned char* lds, int gw, int NGW, int wave, int lane) {
    LAS float* scr = (LAS float*)(lds + wave * 16384);
    const float* Win = a.in[8] + (size_t)l * D * D_IN; const float* Wout = a.in[17] + (size_t)l * D * D;
    const float* W1 = a.in[20] + (size_t)l * D * D_FF; const float* W2 = a.in[22] + (size_t)l * D_FF * D;
    const size_t wb = wbase(l);
    bf16* WinT = (bf16*)(ws + WS_WIN + wb); bf16* WoutT = (bf16*)(ws + WS_WOUT + wb); bf16* W1T = (bf16*)(ws + WS_W1 + wb); bf16* W2T = (bf16*)(ws + WS_W2 + wb);
    constexpr int I_IN = 16 * 88, I_OUT = 16 * 32, I_1 = 16 * 128, I_2 = 64 * 32;
    for (int it = gw; it < I_IN + I_OUT + I_1 + I_2; it += NGW) {
        int r = it;
        if (r < I_IN) { transpose_item(Win, D, D_IN, WinT, scr, r, 88, lane); continue; } r -= I_IN;
        if (r < I_OUT) { transpose_item(Wout, D, D, WoutT, scr, r, 32, lane); continue; } r -= I_OUT;
        if (r < I_1) { transpose_item(W1, D, D_FF, W1T, scr, r, 128, lane); continue; } r -= I_1;
        transpose_item(W2, D_FF, D, W2T, scr, r, 32, lane);
    }
}
__device__ __forceinline__ void mod_phase(const Args& a, unsigned char* ws, LAS unsigned char* lds, int tid, int wave, int lane, int bid, int G) {
    LAS float* sc = (LAS float*)lds;
    LAS float* red = (LAS float*)(lds + 49152);
    float* modbuf = (float*)(ws + WS_MOD);
    for (int i = tid; i < NBATCH * 1024; i += NTHREADS) { const int b = i >> 10, k = i & 1023; const float c = b < 4 ? a.in[2][b * 1024 + k] : a.in[3][(b - 4) * 1024 + k]; sc[i] = c / (1.f + __expf(-c)); }
    __syncthreads();
    for (int unit = bid; unit < DEPTH * 96; unit += G) {
        const int l = unit / 96, jb = unit % 96;
        const float* W = a.in[6] + (size_t)l * D * 6144 + jb * 64 + lane;
        float acc[NBATCH];
#pragma unroll
        for (int b = 0; b < NBATCH; ++b) acc[b] = 0.f;
#pragma unroll 4
        for (int k = wave * 128; k < wave * 128 + 128; ++k) { const float w = W[(size_t)k * 6144];
#pragma unroll
            for (int b = 0; b < NBATCH; ++b) acc[b] += sc[b * 1024 + k] * w; }
#pragma unroll
        for (int b = 0; b < NBATCH; ++b) red[(wave * NBATCH + b) * 64 + lane] = acc[b];
        __syncthreads();
        for (int i = tid; i < NBATCH * 64; i += NTHREADS) { const int b = i >> 6, ln = i & 63; float s = 0.f;
#pragma unroll
            for (int w = 0; w < 8; ++w) s += red[(w * NBATCH + b) * 64 + ln];
            modbuf[(size_t)(l * NBATCH + b) * 6144 + jb * 64 + ln] = s + a.in[7][l * 6144 + jb * 64 + ln]; }
        __syncthreads();
    }
}

__device__ __forceinline__ void ln_rows(const float* xp, const float* xs, bool in_mode, float* X, const float* gam, const float* bet, const float* modl, int sh_off, bf16* XN, float* stats  , int gw, int NGW, int lane) {
#define LN_SRC(m_) (in_mode ? ((m_) < M_P ? xp + (size_t)(m_) * D : xs + (size_t)((m_) - M_P) * D) : X + (size_t)(m_) * D)
#define LN_LOAD(B_, m_) do { const int mq_ = (m_) < M ? (m_) : M - 1; const float* src_ = LN_SRC(mq_); _Pragma("unroll") for (int j = 0; j < 4; ++j) B_[j] = __builtin_nontemporal_load((const f32x4*)src_ + lane + 64 * j); } while (0)
    f32x4 bA[4], bB[4];
    LN_LOAD(bA, gw); LN_LOAD(bB, gw + NGW);
    auto process = [&](f32x4 (&buf)[4], int m) {
        f32x4 v[4]; float s = 0.f;
#pragma unroll
        for (int j = 0; j < 4; ++j) { v[j] = buf[j]; s += (v[j].x + v[j].y) + (v[j].z + v[j].w); }
        LN_LOAD(buf, m + 2 * NGW);
        const float mean = wave_sum(s) * (1.f / D); float s2 = 0.f;
#pragma unroll
        for (int j = 0; j < 4; ++j) { v[j] = v[j] - mean; s2 += (v[j].x * v[j].x + v[j].y * v[j].y) + (v[j].z * v[j].z + v[j].w * v[j].w); }
        const float rstd = 1.f / sqrtf(wave_sum(s2) * (1.f / D) + 1e-5f);
        const float* mrow = modl ? modl + (size_t)batch_of_row(m) * 6144 + sh_off : nullptr;
        if (stats && lane == 0) { stats[2 * (size_t)m] = mean; stats[2 * (size_t)m + 1] = rstd; }
#pragma unroll
        for (int j = 0; j < 4; ++j) { const int c4 = lane + 64 * j;
            const f32x4 y = v[j] * rstd * ((const f32x4*)gam)[c4] + ((const f32x4*)bet)[c4];
            if (!stats) ((f32x4*)(X + (size_t)m * D))[c4] = y;
            if (XN) { const f32x4 h = y * (((const f32x4*)(mrow + 1024))[c4] + 1.0f) + ((const f32x4*)mrow)[c4];
                v2u w; w.x = pk2(h.x, h.y); w.y = pk2(h.z, h.w); ((v2u*)(XN + (size_t)m * D))[c4] = w; } }
    };
#pragma unroll 1
    for (int m = gw; m < M; m += 2 * NGW) { process(bA, m); if (m + NGW < M) process(bB, m + NGW); }
#undef LN_LOAD
#undef LN_SRC
}

__device__ __forceinline__ void conv_items(const bf16* P, bf16* mix, const float* cw  , int first, int stride) {
    const int c0 = (first & 31) * 8;
    f32x4 wt[3][2];
#pragma unroll
    for (int k = 0; k < 3; ++k) { wt[k][0] = *(const f32x4*)(cw + k * 256 + c0); wt[k][1] = *(const f32x4*)(cw + k * 256 + c0 + 4); }
#pragma unroll 2
    for (int it = first; it < M * 32; it += stride) {
        const int m = it >> 5;
        const int b = batch_of_row(m); int row0, S; batch_info(b, row0, S); const int t = m - row0;
        const bf16* pr = P + (size_t)m * D_IN + c0;
        const v4u zz = {0u, 0u, 0u, 0u};
        const v4u bg = *(const v4u*)pr;
        const v4u c1 = *(const v4u*)(pr + 256), u1 = *(const v4u*)(pr + 512);
        const v4u cm = t > 0 ? *(const v4u*)(pr - D_IN + 256) : zz, um = t > 0 ? *(const v4u*)(pr - D_IN + 512) : zz;
        const v4u cp = t < S - 1 ? *(const v4u*)(pr + D_IN + 256) : zz, up = t < S - 1 ? *(const v4u*)(pr + D_IN + 512) : zz;
        v4u o;
#pragma unroll
        for (int e = 0; e < 4; ++e) {
            const float w0l = wt[0][e >> 1][(2 * e) & 3], w0h = wt[0][e >> 1][(2 * e + 1) & 3], w1l = wt[1][e >> 1][(2 * e) & 3], w1h = wt[1][e >> 1][(2 * e + 1) & 3], w2l = wt[2][e >> 1][(2 * e) & 3], w2h = wt[2][e >> 1][(2 * e + 1) & 3];
            const float yl = bflo(bg[e]) * (w0l * bflo(cm[e]) * bflo(um[e]) + w1l * bflo(c1[e]) * bflo(u1[e]) + w2l * bflo(cp[e]) * bflo(up[e]));
            const float yh = bfhi(bg[e]) * (w0h * bfhi(cm[e]) * bfhi(um[e]) + w1h * bfhi(c1[e]) * bfhi(u1[e]) + w2h * bfhi(cp[e]) * bfhi(up[e]));
            o[e] = pk2(yl, yh);
        }
        *(v4u*)(mix + (size_t)m * D + c0) = o;
    }
}

__device__ __forceinline__ void attn_unit(const bf16* P, bf16* mix, const float* sinkl, int u, LAS unsigned char* lds, int tid, int wave, int lane) {
    int b, r;
    if (u < 256) { b = u >> 6; r = u & 63; } else { b = 4 + ((u - 256) >> 7); r = (u - 256) & 127; }
    const int qb = r >> 1, hk = r & 1;
    int row0, S; batch_info(b, row0, S);
    const int q0 = qb * 128;
    LAS bf16* Ks = (LAS bf16*)lds;
    LAS bf16* Vt = (LAS bf16*)(lds + 57600);
    const int fr = lane & 15, fq = lane >> 4;
    const int qa = q0 + 16 * wave;
    const size_t qrow = (size_t)(row0 + qa + fr);
    bf16x8 qfn[2];
#pragma unroll
    for (int ks = 0; ks < 2; ++ks) qfn[ks] = *(const bf16x8*)(P + qrow * D_IN + 768 + (hk * 4) * 64 + 32 * ks + 8 * fq);
    {
        v4u kvr[7], vvr[7];
#pragma unroll
        for (int r = 0; r < 7; ++r) { const int idx = tid + NTHREADS * r; const int dg = idx / 400, kk = idx - dg * 400; const int t = q0 - 128 + kk;
            kvr[r] = (v4u){0u, 0u, 0u, 0u}; vvr[r] = (v4u){0u, 0u, 0u, 0u};
            if (idx < 3200 && t >= 0 && t < S) { const bf16* pr = P + (size_t)(row0 + t) * D_IN + 1280 + hk * 64 + dg * 8; kvr[r] = *(const v4u*)pr; vvr[r] = *(const v4u*)(pr + 128); } }
#pragma unroll
        for (int r = 0; r < 7; ++r) { const int idx = tid + NTHREADS * r; const int dg = idx / 400, kk = idx - dg * 400;
            if (idx < 3200) { *(LAS v4u*)(Ks + kk * 72 + dg * 8) = kvr[r];
#pragma unroll
                for (int e = 0; e < 4; ++e) { Vt[(dg * 8 + 2 * e) * 408 + kk] = (bf16)(vvr[r][e] & 0xffffu); Vt[(dg * 8 + 2 * e + 1) * 408 + kk] = (bf16)(vvr[r][e] >> 16); } } }
    }
    __syncthreads();
#pragma unroll 1
    for (int g = 0; g < 4; ++g) {
        const int h = hk * 4 + g;
        int frl = fr; asm volatile("" : "+v"(frl));
        const float LOG2E = 1.4426950408889634f;
        const float nslope = -exp2f(-(float)(h + 1)) * LOG2E, qs = 0.125f * LOG2E; const float sink2 = sinkl[h] * LOG2E;
        const float relb = (float)(4 * fq - 128 - frl);
        const float rlo = fmaxf(-128.f, -(float)(qa + frl)), rhi = fminf(128.f, (float)(S - 1 - qa - frl));
        const float mid = 0.5f * (rlo + rhi), half = 0.5f * (rhi - rlo);
        bf16x8 qf[2];
#pragma unroll
        for (int ks = 0; ks < 2; ++ks) qf[ks] = qfn[ks];
        { const int hn = h < hk * 4 + 3 ? h + 1 : h;
#pragma unroll
          for (int ks = 0; ks < 2; ++ks) qfn[ks] = *(const bf16x8*)(P + qrow * D_IN + 768 + hn * 64 + 32 * ks + 8 * fq); }
        float sc[18][4]; float mx = -INFINITY;
#pragma unroll
        for (int kt = 0; kt < 17; ++kt) {
            f32x4 acc = {0.f, 0.f, 0.f, 0.f};
#pragma unroll
            for (int ks = 0; ks < 2; ++ks) { const bf16x8 kf = *(const LAS bf16x8*)(Ks + (16 * wave + 16 * kt + fr) * 72 + 32 * ks + 8 * fq); acc = MFMA_BF16(kf, qf[ks], acc); }
#pragma unroll
            for (int j = 0; j < 4; ++j) { const float relf = relb + (float)(16 * kt + j);
                const float t = __builtin_fmaf(fabsf(relf), nslope, acc[j] * qs);
                const float s2 = fabsf(relf - mid) <= half ? t : -INFINITY; sc[kt][j] = s2; mx = fmaxf(mx, s2); }
            if (kt & 1) __builtin_amdgcn_sched_barrier(0);
        }
        mx = fmaxf(mx, __shfl_xor(mx, 16)); mx = fmaxf(mx, __shfl_xor(mx, 32));
        const float mm = fmaxf(mx, sink2);
        float sum = 0.f;
#pragma unroll
        for (int kt = 0; kt < 17; ++kt)
#pragma unroll
            for (int j = 0; j < 4; ++j) { const float e = __builtin_amdgcn_exp2f(sc[kt][j] - mm); sc[kt][j] = e; sum += e; }
#pragma unroll
        for (int j = 0; j < 4; ++j) sc[17][j] = 0.f;
        sum += __shfl_xor(sum, 16); sum += __shfl_xor(sum, 32);
        const float inv = 1.f / (sum + __builtin_amdgcn_exp2f(sink2 - mm));
        bf16x8 pb[9];
#pragma unroll
        for (int c = 0; c < 9; ++c) { v4u w; w.x = pk2(sc[2 * c][0], sc[2 * c][1]); w.y = pk2(sc[2 * c][2], sc[2 * c][3]);
            w.z = pk2(sc[2 * c + 1][0], sc[2 * c + 1][1]); w.w = pk2(sc[2 * c + 1][2], sc[2 * c + 1][3]); pb[c] = __builtin_bit_cast(bf16x8, w); }
#pragma unroll 1
        for (int dt = 0; dt < 4; ++dt) {
            f32x4 acc = {0.f, 0.f, 0.f, 0.f};
#pragma unroll
            for (int c = 0; c < 9; ++c) { const LAS bf16* vp = Vt + (16 * dt + fr) * 408 + 16 * wave + 32 * c + 4 * fq;
                const v2u lo = *(const LAS v2u*)vp, hi = *(const LAS v2u*)(vp + 16);
                v4u w; w.x = lo.x; w.y = lo.y; w.z = hi.x; w.w = hi.y; acc = MFMA_BF16(__builtin_bit_cast(bf16x8, w), pb[c], acc); }
            v2u w; w.x = pk2(acc[0] * inv, acc[1] * inv); w.y = pk2(acc[2] * inv, acc[3] * inv);
            *(v2u*)(mix + qrow * D + 256 + h * 64 + 16 * dt + 4 * fq) = w;
        }
    }
    __syncthreads();
}

__device__ __forceinline__ void dn_prep(const Args& a, unsigned char* ws, int l, LAS unsigned char* lds, int tid, int wave, int lane, int bid, int G) {
    const bf16* P = (const bf16*)(ws + WS_P);
    bf16* dnc = (bf16*)(ws + WS_DNC); bf16* qhat = (bf16*)(ws + WS_QH); float* eg = (float*)(ws + WS_EG); float* egl = (float*)(ws + WS_EGL);
    bf16* negw = dnc, *Am = dnc + 4096, *kdT = dnc + 8192, *uT = dnc + 12288;
    LAS float* qh = (LAS float*)lds;
    LAS float* kh = qh + 64 * 65;
    LAS float* vv = kh + 64 * 65;
    LAS float* Ls = (LAS float*)(lds + 49920);
    LAS float* gcs = (LAS float*)(lds + 82688);
    LAS float* bts = gcs + 128;
    LAS float* bws = bts + 128;
    LAS float* cws = bws + 128;
    const int fr = lane & 15, fq = lane >> 4;
#define LBAR() do { asm volatile("s_waitcnt lgkmcnt(0)" ::: "memory"); __builtin_amdgcn_s_barrier(); asm volatile("" ::: "memory"); } while (0)
    const int NU = NCHUNK * 4;
    LAS unsigned char* rawb = lds + 86528;
    unsigned ga = 0, gb = 0;
    auto load_unit = [&](int unit) {
        const int cgi = unit >> 2, h = unit & 3; const int rowc = cgi * 64;
        const int b = batch_of_row(rowc); int row0, S; batch_info(b, row0, S);
        const int t0 = rowc - row0;
#pragma unroll
        for (int r = 0; r < 4; ++r) { const int p = tid + NTHREADS * r;
            if (p < 1584) { const int rr = p / 24, c = p % 24; int t = t0 - 1 + rr; t = t < 0 ? 0 : (t > S - 1 ? S - 1 : t);
                __builtin_amdgcn_global_load_lds((const unsigned*)(P + (size_t)(row0 + t) * D_IN + 1536 + (c >> 3) * 256 + h * 64 + (c & 7) * 8), (LAS unsigned*)(rawb + r * 8192 + wave * 1024), 16, 0, 0); } }
        if (wave < 2) { const int io = wave ? 63 - lane : lane; const bf16* pg = P + (size_t)(rowc + io) * D_IN + 2560 + h; ga = pg[wave * 4]; gb = pg[8 + wave * 4]; }
    };
    int h_loaded = -1;
    if (bid < NU) load_unit(bid);
    asm volatile("s_waitcnt vmcnt(0)" ::: "memory"); LBAR();
    for (int unit = bid; unit < NU; unit += G) {
        const int cgi = unit >> 2, h = unit & 3;
        const int rowc = cgi * 64;
        const size_t cid0 = ((size_t)cgi * 4 + h) * 2;
        int S, t0; { const int b = batch_of_row(rowc); int row0; batch_info(b, row0, S); t0 = rowc - row0; }
        if (h != h_loaded) {
            for (int i = tid; i < 576; i += NTHREADS) { const int k = i / 192, r = i % 192; cws[i] = a.in[11][(size_t)l * 2304 + k * 768 + (r >> 6) * 256 + h * 64 + (r & 63)]; }
            h_loaded = h; LBAR();
        }
        const unsigned gca = ga, gcb = gb;
        { const int i = tid >> 3, dg = tid & 7; const int t = t0 + i;
          const v4u zz = {0u, 0u, 0u, 0u};
#pragma unroll
          for (int wq = 0; wq < 3; ++wq) {
              const LAS unsigned char* rp = rawb + ((i * 24) + wq * 8 + dg) * 16;
              const v4u r0 = t > 0 ? *(const LAS v4u*)rp : zz, r1 = *(const LAS v4u*)(rp + 384), r2 = t < S - 1 ? *(const LAS v4u*)(rp + 768) : zz;
              LAS float* dst = (wq == 0 ? qh : (wq == 1 ? kh : vv)) + i * 65 + dg * 8;
              const LAS float* c0 = cws + wq * 64 + dg * 8;
#pragma unroll
              for (int e = 0; e < 4; ++e) {
                  float yl = c0[2 * e] * bflo(r0[e]) + c0[192 + 2 * e] * bflo(r1[e]) + c0[384 + 2 * e] * bflo(r2[e]);
                  float yh = c0[2 * e + 1] * bfhi(r0[e]) + c0[192 + 2 * e + 1] * bfhi(r1[e]) + c0[384 + 2 * e + 1] * bfhi(r2[e]);
                  dst[2 * e] = yl / (1.f + __expf(-yl)); dst[2 * e + 1] = yh / (1.f + __expf(-yh));
              }
          } }
        LBAR();
        if (unit + G < NU) load_unit(unit + G);
        { const int pair = tid >> 2, sub = tid & 3, which = pair >> 6, i = pair & 63;
          LAS float* rowp = (which ? kh : qh) + i * 65 + sub * 16;
          float vals[16]; float s = 0.f;
#pragma unroll
          for (int e = 0; e < 16; ++e) { vals[e] = rowp[e]; s += vals[e] * vals[e]; }
          s += __shfl_xor(s, 1); s += __shfl_xor(s, 2);
          const float rs = (1.f / sqrtf(s + 1e-6f)) * (which ? 1.f : 0.125f);
#pragma unroll
          for (int e = 0; e < 16; ++e) rowp[e] = vals[e] * rs; }
        if (wave < 2) { const int dir = wave, ip = lane, io = dir ? 63 - ip : ip;
          const float av = bf1((bf16)gca), bv = bf1((bf16)gcb); (void)io;
          const float alog = a.in[12 + dir][l * 4 + h], dtb = a.in[14 + dir][l * 4 + h];
          const float xx = av + dtb; const float sp = xx > 20.f ? xx : __logf(1.f + __expf(xx));
          const float gg = -__expf(alog) * sp; const float beta = 1.f / (1.f + __expf(-bv));
          float c = gg;
#pragma unroll
          for (int off = 1; off < 64; off <<= 1) { const float tt = __shfl_up(c, off); if (lane >= off) c += tt; }
          gcs[dir * 64 + ip] = c; bts[dir * 64 + ip] = beta; bws[dir * 64 + ip] = beta * __expf(c); }
        LBAR();
        { const int which = wave >> 2, ti = wave & 3;
          const LAS float* Arow = (which ? qh : kh) + (16 * ti + fr) * 65;
          f32x4 acc[4];
#pragma unroll
          for (int tj = 0; tj < 4; ++tj) acc[tj] = (f32x4){0.f, 0.f, 0.f, 0.f};
#pragma unroll
          for (int kk = 0; kk < 16; ++kk) { const float av = Arow[4 * kk + fq];
#pragma unroll
              for (int tj = 0; tj < 4; ++tj) { const float bv = kh[(16 * tj + fr) * 65 + 4 * kk + fq]; acc[tj] = __builtin_amdgcn_mfma_f32_16x16x4f32(av, bv, acc[tj], 0, 0, 0); } }
#pragma unroll
          for (int tj = 0; tj < 4; ++tj)
#pragma unroll
              for (int j = 0; j < 4; ++j) { const int i = 16 * ti + 4 * fq + j, jc = 16 * tj + fr, i1 = 63 - i, j1 = 63 - jc; const float val = acc[tj][j];
                  if (which == 0) {
                      const float d0 = jc < i ? gcs[i] - gcs[jc] : 0.f, d1 = j1 < i1 ? gcs[64 + i1] - gcs[64 + j1] : 0.f;
                      Ls[i * 64 + jc] = jc < i ? bts[i] * val * __expf(d0) : 0.f;
                      Ls[4096 + i1 * 64 + j1] = j1 < i1 ? bts[64 + i1] * val * __expf(d1) : 0.f;
                  } else {
                      const float d0 = jc <= i ? gcs[i] - gcs[jc] : 0.f, d1 = j1 <= i1 ? gcs[64 + i1] - gcs[64 + j1] : 0.f;
                      Am[cid0 * 16384 + i * 64 + (jc & 32) + ppos(jc & 31)] = f2bf(jc <= i ? val * __expf(d0) : 0.f);
                      Am[(cid0 + 1) * 16384 + i1 * 64 + (j1 & 32) + ppos(j1 & 31)] = f2bf(j1 <= i1 ? val * __expf(d1) : 0.f);
                  } } }
        asm volatile("s_waitcnt vmcnt(0)" ::: "memory");
        LBAR();
        int tid4 = tid; asm volatile("" : "+v"(tid4));
        if (wave < 4) {
            const int dir = wave >> 1, col = tid4 & 127; const bool isW = (wave & 1) != 0;
            int st = dir ? -65 : 65; asm volatile("" : "+v"(st));
            const LAS float* sp = (isW ? kh + (col - 64) : vv + col) + (dir ? 63 * 65 : 0);
            const LAS float* scl = (isW ? bws : bts) + dir * 64;
            const LAS float* Lr = Ls + dir * 4096;
            const size_t cid = cid0 + dir;
            float x[64];
#pragma unroll
            for (int i = 0; i < 64; ++i) x[i] = 0.f;
#pragma unroll
            for (int i = 0; i < 64; ++i) {
                f32x4 lb[16];
                float acc = scl[i] * *sp; sp += st;
#pragma unroll
                for (int j4 = 0; j4 < (i + 3) / 4; ++j4) lb[j4] = *(const LAS f32x4*)(Lr + i * 64 + 4 * j4);
                __builtin_amdgcn_sched_barrier(0);
#pragma unroll
                for (int j4 = 0; j4 < (i + 3) / 4; ++j4) { const f32x4 l4 = lb[j4];
                    acc -= l4.x * x[4 * j4]; acc -= l4.y * x[4 * j4 + 1]; acc -= l4.z * x[4 * j4 + 2]; acc -= l4.w * x[4 * j4 + 3]; }
                x[i] = acc;
                __builtin_amdgcn_sched_barrier(0);
            }
            if (!isW) {
                bf16* dst = uT + cid * 16384 + col * 64;
#pragma unroll
                for (int q = 0; q < 8; ++q) { v4u w; w.x = pk2(x[8 * q], x[8 * q + 1]); w.y = pk2(x[8 * q + 2], x[8 * q + 3]); w.z = pk2(x[8 * q + 4], x[8 * q + 5]); w.w = pk2(x[8 * q + 6], x[8 * q + 7]); *(v4u*)(dst + 8 * q) = w; }
            } else {
                const int dk = col - 64; bf16* dst = negw + cid * 16384 + (dk & 32) + ppos(dk & 31);
#pragma unroll
                for (int i = 0; i < 64; ++i) dst[i * 64] = f2bf(-x[i]);
            }
        } else {
            const int t2 = tid4 - 256; const int lane4 = tid4 & 63;
            { const int i = t2 >> 2, part = t2 & 3, g32 = (part >> 1) * 32, pb = (part & 1) * 16;
              const LAS float* qr = qh + i * 65 + g32;
              v4u w0, w1;
#pragma unroll
              for (int e = 0; e < 4; ++e) { w0[e] = pk2(qr[dmap(pb + 2 * e)], qr[dmap(pb + 2 * e + 1)]); w1[e] = pk2(qr[dmap(pb + 8 + 2 * e)], qr[dmap(pb + 8 + 2 * e + 1)]); }
              bf16* dst = qhat + (size_t)(rowc + i) * 256 + h * 64 + 16 * part; *(v4u*)dst = w0; *(v4u*)(dst + 8) = w1; }
            const int dir = (wave - 4) >> 1; const size_t cid = cid0 + dir;
            if (((wave - 4) & 1) == 0) {
                const int dk = lane4; const float gl = gcs[dir * 64 + 63];
                int st = dir ? -65 : 65; asm volatile("" : "+v"(st));
                const LAS float* kb = kh + dk + (dir ? 63 * 65 : 0);
                bf16* dst = kdT + cid * 16384 + dk * 64;
#pragma unroll
                for (int q = 0; q < 8; ++q) { float vals[8];
#pragma unroll
                    for (int e = 0; e < 8; ++e) { const int pos = 8 * q + e; const int ip = (pos & 32) + dmap(pos & 31); vals[e] = kb[ip * st] * __expf(gl - gcs[dir * 64 + ip]); }
                    v4u w; w.x = pk2(vals[0], vals[1]); w.y = pk2(vals[2], vals[3]); w.z = pk2(vals[4], vals[5]); w.w = pk2(vals[6], vals[7]); *(v4u*)(dst + 8 * q) = w; }
            } else {
                const float e = __expf(gcs[dir * 64 + lane4]); eg[cid * 64 + lane4] = e; if (lane4 == 63) egl[cid] = e;
            }
        }
        LBAR();
    }
}

__device__ __forceinline__ void dn_scan_block(unsigned char* ws, int ch, LAS unsigned char* lds, int wave, int lane) {
    bf16* P = (bf16*)(ws + WS_P);
    const bf16* uT = (const bf16*)(ws + WS_DNC) + 12288; const float* eg = (const float*)(ws + WS_EG); const float* egl = (const float*)(ws + WS_EGL);
    int b, h, dir;
    if (ch < 64) { b = 4 + (ch >> 3); h = (ch >> 1) & 3; dir = ch & 1; } else { const int c2 = ch - 64; b = c2 >> 3; h = (c2 >> 1) & 3; dir = c2 & 1; }
    int row0, S; batch_info(b, row0, S);
    const int N = S >> 6, chunk0 = row0 >> 6;
    const int fr = lane & 15, fq = lane >> 4;
#define SCAN_CID(n_) (((size_t)(chunk0 + (dir ? N - 1 - (n_) : (n_))) * 4 + h) * 2 + dir)
    auto flush_o = [&](int n, int lw) {
        const size_t cid = SCAN_CID(n); const int rowc = (int)(cid >> 3) * 64;
        const LAS unsigned char* ob = lds + 131072 + (n & 1) * 8192;
#pragma unroll
        for (int r = 0; r < 2; ++r) { const int tl = lw * 16 + r * 8 + (lane >> 3), c8 = (lane & 7) * 8;
            const v4u w = *(const LAS v4u*)(ob + tl * 128 + c8 * 2);
            *(v4u*)(P + (size_t)(rowc + (dir ? 63 - tl : tl)) * D_IN + 1536 + dir * 256 + h * 64 + c8) = w; }
    };
    if (wave >= 4) {
        const int lw = wave - 4;
        const unsigned char* abase = ws + WS_DNC + (lw == 0 ? 0 : (lw == 2 ? 8192 : 16384));
        const unsigned lane_off = (unsigned)(fr * 128 + fq * 16);
        auto issue = [&](int n) {
            const int nn = n < N ? n : N - 1;
            const size_t cid = SCAN_CID(nn);
            LAS unsigned char* dst = lds + (nn & 3) * 32768 + lw * 8192;
            if (lw != 1) {
                const unsigned char* src = abase + cid * 32768 + lane_off;
#pragma unroll
                for (int m = 0; m < 4; ++m)
#pragma unroll
                    for (int ks = 0; ks < 2; ++ks)
                        __builtin_amdgcn_global_load_lds((const unsigned*)(src + m * 2048 + ks * 64), (LAS unsigned*)(dst + (m * 2 + ks) * 1024), 16, 0, 0);
            } else {
                const int rowc = (int)(cid >> 3) * 64;
#pragma unroll
                for (int m = 0; m < 4; ++m) { const int tl = 16 * m + fr; const unsigned char* src = ws + WS_QH + (size_t)(rowc + (dir ? 63 - tl : tl)) * 512 + h * 128 + fq * 16;
#pragma unroll
                    for (int ks = 0; ks < 2; ++ks)
                        __builtin_amdgcn_global_load_lds((const unsigned*)(src + ks * 64), (LAS unsigned*)(dst + (m * 2 + ks) * 1024), 16, 0, 0); }
            }
        };
        issue(0); issue(1); issue(2);
        asm volatile("s_waitcnt vmcnt(16)" ::: "memory"); __builtin_amdgcn_s_barrier(); asm volatile("" ::: "memory");
        for (int n = 0; n < N; ++n) {
            issue(n + 3);
            asm volatile("s_waitcnt vmcnt(16)" ::: "memory"); __builtin_amdgcn_s_barrier(); asm volatile("" ::: "memory");
        }
        asm volatile("s_waitcnt vmcnt(0)" ::: "memory");
    } else {
        const int e0 = 16 * wave;
        f32x4 St[4];
#pragma unroll
        for (int dt = 0; dt < 4; ++dt) St[dt] = (f32x4){0.f, 0.f, 0.f, 0.f};
        int vz = 0; asm volatile("" : "+v"(vz));
        struct Priv { v2u ur[4]; f32x4 eg[4]; float el; };
        Priv b0, b1, b2, b3;
#define SCAN_LDP(n_, B_) do { const int nq_ = (n_) < N ? (n_) : N - 1; const size_t cq_ = SCAN_CID(nq_); \
        _Pragma("unroll") for (int m = 0; m < 4; ++m) { B_.ur[m] = *(const v2u*)(uT + cq_ * 16384 + (e0 + fr) * 64 + 16 * m + 4 * fq); B_.eg[m] = *(const f32x4*)(eg + cq_ * 64 + 16 * m + 4 * fq); } \
        B_.el = egl[cq_ + vz]; } while (0)
        SCAN_LDP(0, b0); SCAN_LDP(1, b1); SCAN_LDP(2, b2);
#define SCAN_PIN(B_) do { _Pragma("unroll") for (int m = 0; m < 4; ++m) asm volatile("" : "+v"(B_.ur[m]), "+v"(B_.eg[m])); asm volatile("" : "+v"(B_.el)); } while (0)
        SCAN_PIN(b0); SCAN_PIN(b1); SCAN_PIN(b2);
        asm volatile("" ::: "memory"); __builtin_amdgcn_s_barrier(); asm volatile("" ::: "memory");
        auto body = [&](int n, const Priv& cur, Priv& nxt) {
            if (n > 0) flush_o(n - 1, wave);
            SCAN_LDP(n + 3, nxt);
            const LAS unsigned char* st = lds + (n & 3) * 32768 + lane * 16;
#define FRAG(arr, m, ks) (*(const LAS bf16x8*)(st + (arr) * 8192 + ((m) * 2 + (ks)) * 1024))
            bf16x8 Sb[2], Vb[2];
            bf16x8 fa[4][2], fb[4][2];
#pragma unroll
            for (int m = 0; m < 4; ++m)
#pragma unroll
                for (int ks = 0; ks < 2; ++ks) { fa[m][ks] = FRAG(0, m, ks); fb[m][ks] = FRAG(1, m, ks); }
#pragma unroll
            for (int ks = 0; ks < 2; ++ks) { v4u w; w.x = pk2(St[2 * ks][0], St[2 * ks][1]); w.y = pk2(St[2 * ks][2], St[2 * ks][3]); w.z = pk2(St[2 * ks + 1][0], St[2 * ks + 1][1]); w.w = pk2(St[2 * ks + 1][2], St[2 * ks + 1][3]); Sb[ks] = __builtin_bit_cast(bf16x8, w); }
            __builtin_amdgcn_sched_barrier(0);
            f32x4 vn[4], oo[4];
#pragma unroll
            for (int m = 0; m < 4; ++m) {
                f32x4 acc = {bflo(cur.ur[m].x), bfhi(cur.ur[m].x), bflo(cur.ur[m].y), bfhi(cur.ur[m].y)};
                acc = MFMA_BF16(fa[m][0], Sb[0], acc); acc = MFMA_BF16(fa[m][1], Sb[1], acc); vn[m] = acc;
                f32x4 o = {0.f, 0.f, 0.f, 0.f};
                o = MFMA_BF16(fb[m][0], Sb[0], o); o = MFMA_BF16(fb[m][1], Sb[1], o); oo[m] = o * cur.eg[m];
            }
#pragma unroll
            for (int m = 0; m < 4; ++m)
#pragma unroll
                for (int ks = 0; ks < 2; ++ks) { fa[m][ks] = FRAG(3, m, ks); fb[m][ks] = FRAG(2, m, ks); }
            __builtin_amdgcn_sched_barrier(0);
#pragma unroll
            for (int ks = 0; ks < 2; ++ks) { v4u w; w.x = pk2(vn[2 * ks][0], vn[2 * ks][1]); w.y = pk2(vn[2 * ks][2], vn[2 * ks][3]); w.z = pk2(vn[2 * ks + 1][0], vn[2 * ks + 1][1]); w.w = pk2(vn[2 * ks + 1][2], vn[2 * ks + 1][3]); Vb[ks] = __builtin_bit_cast(bf16x8, w); }
#pragma unroll
            for (int dt = 0; dt < 4; ++dt) { f32x4 s2 = St[dt] * cur.el; s2 = MFMA_BF16(fa[dt][0], Vb[0], s2); s2 = MFMA_BF16(fa[dt][1], Vb[1], s2); St[dt] = s2; }
            LAS bf16* ob = (LAS bf16*)(lds + 131072 + (n & 1) * 8192) + e0 + fr;
#pragma unroll
            for (int m = 0; m < 4; ++m) {
                f32x4 o = oo[m]; o = MFMA_BF16(fb[m][0], Vb[0], o); o = MFMA_BF16(fb[m][1], Vb[1], o);
#pragma unroll
                for (int j = 0; j < 4; ++j) ob[(16 * m + 4 * fq + j) * 64] = f2bf(o[j]);
            }
#undef FRAG
            asm volatile("s_waitcnt lgkmcnt(0)" ::: "memory"); __builtin_amdgcn_s_barrier(); asm volatile("" ::: "memory");
        };
#pragma unroll 1
        for (int n = 0; n < N; n += 4) { body(n, b0, b3); body(n + 1, b1, b0); body(n + 2, b2, b1); body(n + 3, b3, b2); }
        flush_o(N - 1, wave);
    }
#undef SCAN_LDP
#undef SCAN_PIN
#undef SCAN_CID
}

__device__ __forceinline__ void dn_post(const bf16* P, bf16* mix, const float* ng  , int gw, int NGW, int lane) {
    const int half = lane >> 5, c = (lane & 31) * 8;
    const f32x4 g0 = *(const f32x4*)(ng + (c & 63)), g1 = *(const f32x4*)(ng + (c & 63) + 4);
    v4u ofn = {0u, 0u, 0u, 0u}, obn = ofn, zzn = ofn;
    if (gw < M / 2) { const bf16* pr = P + (size_t)(2 * gw + half) * D_IN; ofn = __builtin_nontemporal_load((const v4u*)(pr + 1536 + c)); obn = __builtin_nontemporal_load((const v4u*)(pr + 1792 + c)); zzn = __builtin_nontemporal_load((const v4u*)(pr + 2304 + c)); }
#pragma unroll 1
    for (int pk = gw; pk < M / 2; pk += NGW) {
        const v4u of = ofn, ob = obn, zz = zzn;
        { const int pn = pk + NGW < M / 2 ? pk + NGW : pk; const bf16* pr = P + (size_t)(2 * pn + half) * D_IN; ofn = __builtin_nontemporal_load((const v4u*)(pr + 1536 + c)); obn = __builtin_nontemporal_load((const v4u*)(pr + 1792 + c)); zzn = __builtin_nontemporal_load((const v4u*)(pr + 2304 + c)); }
        float o[8], z[8]; float ss = 0.f;
#pragma unroll
        for (int e = 0; e < 4; ++e) { o[2 * e] = bflo(of[e]) + bflo(ob[e]); o[2 * e + 1] = bfhi(of[e]) + bfhi(ob[e]); z[2 * e] = bflo(zz[e]); z[2 * e + 1] = bfhi(zz[e]);
            ss += o[2 * e] * o[2 * e] + o[2 * e + 1] * o[2 * e + 1]; }
        ss += __shfl_xor(ss, 1); ss += __shfl_xor(ss, 2); ss += __shfl_xor(ss, 4);
        const float r = 1.f / sqrtf(ss * (1.f / 64.f) + 1e-6f);
        v4u w;
#pragma unroll
        for (int e = 0; e < 4; ++e) { const float ga = e < 2 ? g0[2 * e] : g1[2 * e - 4], gb = e < 2 ? g0[2 * e + 1] : g1[2 * e - 3];
            const float ya = o[2 * e] * r * ga * (z[2 * e] / (1.f + __expf(-z[2 * e]))), yb = o[2 * e + 1] * r * gb * (z[2 * e + 1] / (1.f + __expf(-z[2 * e + 1])));
            w[e] = pk2(ya, yb); }
        *(v4u*)(mix + (size_t)(2 * pk + half) * D + 768 + c) = w;
    }
}

#ifndef MK_DEBUG
#define MK_DEBUG 0
#endif
#if MK_DEBUG
constexpr size_t WS_FLAG = WS_END;
__device__ __forceinline__ bool bad16(unsigned u) { return (u & 0x7f80u) >= (147u << 7); }
__device__ __forceinline__ bool bad32(unsigned u) { return (u & 0x7f800000u) >= (147u << 23); }
__global__ void __launch_bounds__(512) dbg_scan(const unsigned* buf, size_t nwords, int is16, unsigned* flag, int code) {
    bool bad = false;
    for (size_t i = (size_t)blockIdx.x * 512 + threadIdx.x; i < nwords; i += (size_t)gridDim.x * 512) { const unsigned u = buf[i]; bad |= is16 ? (bad16(u) || bad16(u >> 16)) : bad32(u); }
    if (bad) atomicMin(flag, (unsigned)code);
}
__global__ void __launch_bounds__(512) dbg_scan2(const unsigned short* buf, int rows, int ld, int c0, int nc, unsigned* flag, int code) {
    bool bad = false;
    for (size_t i = (size_t)blockIdx.x * 512 + threadIdx.x; i < (size_t)rows * nc; i += (size_t)gridDim.x * 512) { const size_t r = i / nc; const int c = (int)(i % nc); bad |= bad16(buf[r * ld + c0 + c]); }
    if (bad) atomicMin(flag, (unsigned)code);
}
__global__ void __launch_bounds__(512) dbg_fin(float* out, size_t n, const unsigned* flag) {
    const unsigned f = *flag; if (f == 0x7f7f7f7fu) return;
    const float v = sqrtf((float)(f + 1));
    for (size_t i = (size_t)blockIdx.x * 512 + threadIdx.x; i < n; i += (size_t)gridDim.x * 512) out[i] = v;
}
#endif
constexpr size_t WS_BAR = 1966080;
#define RLX_AGENT __ATOMIC_RELAXED, __HIP_MEMORY_SCOPE_AGENT
#define XB_TMO      128
#define XB_XCNT(j)  (256  + 64 * (j))
#define XB_XSUB(j)  (1280 + 64 * (j))
#define XB_XGEN(j)  (2304 + 64 * (j))
#define XB_TOP      3328
#define XB_TOPGEN   3392
#define XCD_BAR_WORDS 3456
#define XB_SPIN_CAP (1u << 18)

__device__ __forceinline__ unsigned xb_ld(unsigned* p)              { return __hip_atomic_load(p, __ATOMIC_RELAXED, __HIP_MEMORY_SCOPE_AGENT); }
__device__ __forceinline__ unsigned xb_add(unsigned* p, unsigned v) { return __hip_atomic_fetch_add(p, v, __ATOMIC_RELAXED, __HIP_MEMORY_SCOPE_AGENT); }
__device__ __forceinline__ unsigned xb_xcc_id() { return (unsigned)__builtin_amdgcn_s_getreg((3 << 11) | 20) & 0xFu; }
#define XB_SPIN(cond, bar) do { unsigned _sp = 0; while (cond) { __builtin_amdgcn_s_sleep(1); \
    if ((++_sp & 255u) == 0u) { if (xb_ld(&(bar)[XB_TMO])) break; if (_sp > XB_SPIN_CAP) { atomicAdd(&(bar)[XB_TMO], 1u); break; } } } } while (0)

struct XcdBarrier {
    unsigned* bar; unsigned x;
    volatile LAS unsigned* st;
};

__device__ __forceinline__ XcdBarrier xcd_barrier_post(unsigned* bar, volatile LAS unsigned* st) {
    XcdBarrier b; b.bar = bar; b.x = xb_xcc_id(); b.st = st;
    if (threadIdx.x == 0) (void)xb_add(&bar[XB_XCNT(b.x)], 1u);
    return b;
}
__device__ __forceinline__ void xcd_barrier_complete(unsigned* bar, unsigned x, unsigned& nloc, unsigned& nx) {
    const unsigned G = gridDim.x * gridDim.y * gridDim.z;
    unsigned sum, cnt, mine, sp = 0u;
    for (;;) {
        sum = 0u; cnt = 0u; mine = 0u;
#pragma unroll
        for (unsigned j = 0; j < 16; ++j) { const unsigned c = xb_ld(&bar[XB_XCNT(j)]); sum += c; cnt += (c > 0u) ? 1u : 0u; mine = (j == x) ? c : mine; }
        if (sum == G) break;
        __builtin_amdgcn_s_sleep(1);
        if ((++sp & 255u) == 0u) { if (xb_ld(&bar[XB_TMO])) break; if (sp > XB_SPIN_CAP) { atomicAdd(&bar[XB_TMO], 1u); break; } }
    }
    nloc = mine > 0u ? mine : 1u; nx = cnt > 0u ? cnt : 1u;
}

__device__ __forceinline__ void xcd_barrier(const XcdBarrier& b) {
    asm volatile("s_waitcnt vmcnt(0)" ::: "memory");
    __syncthreads();
    if (threadIdx.x == 0) {
        unsigned* bar = b.bar;
        __builtin_amdgcn_s_waitcnt(0);
        unsigned nloc = b.st[0], nx = b.st[1];
        if (nloc == 0u) { xcd_barrier_complete(bar, b.x, nloc, nx); b.st[0] = nloc; b.st[1] = nx; }
        const unsigned old = xb_add(&bar[XB_XSUB(b.x)], 1u);
        const unsigned gen = old / nloc;
        if (old + 1u == (gen + 1u) * nloc) {
            __builtin_amdgcn_fence(__ATOMIC_RELEASE, "agent");
            asm volatile("s_waitcnt vmcnt(0)" ::: "memory");
            const unsigned og = xb_add(&bar[XB_TOP], 1u);
            const unsigned tg = og / nx;
            if (og + 1u == (tg + 1u) * nx) xb_add(&bar[XB_TOPGEN], 1u);
            else XB_SPIN(xb_ld(&bar[XB_TOPGEN]) == tg, bar);
            __builtin_amdgcn_fence(__ATOMIC_ACQUIRE, "agent");
            xb_add(&bar[XB_XGEN(b.x)], 1u);
            asm volatile("s_waitcnt vmcnt(0)" ::: "memory");
        } else {
            XB_SPIN(xb_ld(&bar[XB_XGEN(b.x)]) == gen, bar);
            __builtin_amdgcn_fence(__ATOMIC_ACQUIRE, "agent");
            asm volatile("s_waitcnt vmcnt(0)" ::: "memory");
        }
    }
    __syncthreads();
}

__global__ void __launch_bounds__(NTHREADS, 2) mega(Args a) {
    extern __shared__ __attribute__((aligned(16))) unsigned char lds_raw[];
#ifndef MK_TQOFF
#define MK_TQOFF 0.5f
#endif
#ifndef MK_TIMEPH
#define MK_TIMEPH -1
#endif
#if MK_TIMEPH >= 0
    unsigned long long tacc = 0, tprev = __builtin_amdgcn_s_memrealtime();
#endif
    volatile LAS unsigned* xst = (volatile LAS unsigned*)((LAS unsigned char*)lds_raw + 147456);
    if (threadIdx.x < 2) xst[threadIdx.x] = 0u;
    __syncthreads();
    XcdBarrier xbar = xcd_barrier_post((unsigned*)(a.ws + WS_BAR), xst);
    for (int p = a.ph_lo; p < a.ph_hi; ++p) {
        int tid = threadIdx.x; asm volatile("" : "+v"(tid));
        int bid = blockIdx.x; asm volatile("" : "+s"(bid));
        int G = gridDim.x; asm volatile("" : "+s"(G));
        size_t zoff = 0; asm volatile("" : "+s"(zoff));
        unsigned char* ws = a.ws + zoff;
        float* X = a.out + zoff;
        unsigned ldsoff = 0; asm volatile("" : "+s"(ldsoff));
        LAS unsigned char* lds = (LAS unsigned char*)lds_raw + ldsoff;
        const int lane = tid & 63, wave = __builtin_amdgcn_readfirstlane(tid >> 6);
        const int gw = bid * 8 + wave, NGW = G * 8;
        bf16* XN = (bf16*)(ws + WS_XN); bf16* P = (bf16*)(ws + WS_P); bf16* H = (bf16*)(ws + WS_H);
        const float* modbuf = (const float*)(ws + WS_MOD); float* stats = (float*)(ws + WS_STATS);
        int l = 0, pp = p;
        if (p >= 2) { l = (p - 2) / 9; pp = 2 + (p - 2) % 9; }
        const float* modl = modbuf + (size_t)l * NBATCH * 6144;
#ifndef PHMASK
#define PHMASK 0xFFFF
#endif
#define PH_ON(k) (((PHMASK) >> (k)) & 1)
        switch (pp) {
        case 0: if (!PH_ON(0)) break; for (int cl = 0; cl < DEPTH; ++cl) convert_layer(a, ws, cl, lds, gw, NGW, wave, lane); __syncthreads(); mod_phase(a, ws, lds, tid, wave, lane, bid, G); break;
        case 1: if (!PH_ON(1)) break; ln_rows(a.in[0], a.in[1], true, X, a.in[4], a.in[5], modbuf, 0, XN, stats, gw, NGW, lane); break;
        case 2: if (!PH_ON(2)) break; { pg8::Gemm g{XN, (const bf16*)(ws + WS_WIN + wbase(l)), M, D_INP, D}; pg8::StaticOrder S; S.init(M, D_INP, G, bid); pg8::EpiP E{P};
                  pg8::gemm_phase<pg8::EpiP, pg8::StaticOrder, true, true>(lds, g, S, E, tid); } break;
        case 3: if (!PH_ON(3)) break; dn_prep(a, ws, l, lds, tid, wave, lane, bid, G); break;
        case 4: if (!PH_ON(4)) break; if (bid < NSCAN) { if (PH_ON(11)) dn_scan_block(ws, bid, lds, wave, lane); }
                else if (PH_ON(12)) { const int na = G - NSCAN, ab = bid - NSCAN;
                    const int vb = ((na & 7) == 0 && (NSCAN & 7) == 0) ? (ab & 7) * (na >> 3) + (ab >> 3) : ab;
#pragma unroll 1
                    for (int u = vb; u < 1280; u += na) attn_unit(P, XN, a.in[10] + l * 8, u, lds, tid, wave, lane);
                    conv_items(P, XN, a.in[9] + (size_t)l * 768, ab * NTHREADS + tid, na * NTHREADS); }
                break;
        case 5: if (!PH_ON(5)) break; dn_post(P, XN, a.in[16] + l * 64, gw, NGW, lane); break;
        case 6: if (!PH_ON(6)) break; { pg8::Gemm g{XN, (const bf16*)(ws + WS_WOUT + wbase(l)), M, D, D}; pg8::StaticOrder S; S.init(M, D, G, bid); pg8::EpiRes E{X, modl + 2048, nullptr, stats, l > 0 ? a.in[24] + (l - 1) * D : a.in[4], l > 0 ? a.in[25] + (l - 1) * D : a.in[5], l > 0 ? nullptr : a.in[0], l > 0 ? nullptr : a.in[1]};
                  pg8::gemm_phase<pg8::EpiRes, pg8::StaticOrder, true, true>(lds, g, S, E, tid); } break;
        case 7: if (!PH_ON(7)) break; ln_rows(nullptr, nullptr, false, X, a.in[18] + l * D, a.in[19] + l * D, modl, 3072, XN, stats, gw, NGW, lane); break;
        case 8: if (!PH_ON(8)) break; { pg8::Gemm g{XN, (const bf16*)(ws + WS_W1 + wbase(l)), M, D_FF, D}; pg8::StaticOrder S; S.init(M, D_FF, G, bid); pg8::EpiH E{H, a.in[21] + (size_t)l * D_FF};
                  pg8::gemm_phase<pg8::EpiH, pg8::StaticOrder, true, true>(lds, g, S, E, tid); } break;
        case 9: if (!PH_ON(9)) break; { pg8::Gemm g{H, (const bf16*)(ws + WS_W2 + wbase(l)), M, D, D_FF}; pg8::StaticOrder S; S.init(M, D, G, bid); pg8::EpiRes E{X, modl + 5120, a.in[23] + (size_t)l * D, stats, a.in[18] + l * D, a.in[19] + l * D, nullptr, nullptr};
                  pg8::gemm_phase<pg8::EpiRes, pg8::StaticOrder, true, true>(lds, g, S, E, tid); } break;
        case 10: if (!PH_ON(10)) break; if (l < DEPTH - 1) { ln_rows(nullptr, nullptr, false, X, a.in[24] + l * D, a.in[25] + l * D, modl + (size_t)NBATCH * 6144, 0, XN, stats, gw, NGW, lane); }
                 else ln_rows(nullptr, nullptr, false, X, a.in[24] + l * D, a.in[25] + l * D, nullptr, 0, nullptr, nullptr, gw, NGW, lane);
                 break;
        }
#if MK_TIMEPH >= 0
        { const unsigned long long t0 = __builtin_amdgcn_s_memrealtime();
          cg::this_grid().sync();
          const unsigned long long t1 = __builtin_amdgcn_s_memrealtime();
          if (MK_TIMEPH == 100 || pp == MK_TIMEPH) tacc += t1 - tprev; else if (MK_TIMEPH == 200 + pp) tacc += t1 - t0;
          tprev = t1; }
#else
        if (p + 1 < a.ph_hi) { if (p == a.ph_lo) cg::this_grid().sync(); else xcd_barrier(xbar); }
#endif
    }
#if MK_TIMEPH >= 0
    { unsigned* tw = (unsigned*)(a.ws + WS_END);
      if (blockIdx.x == 0 && threadIdx.x == 0) __hip_atomic_store(tw, (unsigned)(tacc / 100), __ATOMIC_RELAXED, __HIP_MEMORY_SCOPE_AGENT);
      cg::this_grid().sync();
      const float tq = floorf(__logf(fmaxf((float)__hip_atomic_load(tw, __ATOMIC_RELAXED, __HIP_MEMORY_SCOPE_AGENT), 1.f)) * (1.f / 0.4054651f) + MK_TQOFF); const float v = sqrtf(__expf((tq - MK_TQOFF + 0.5f) * 0.4054651f));
      for (size_t i = (size_t)blockIdx.x * NTHREADS + threadIdx.x; i < (size_t)M * D; i += (size_t)gridDim.x * NTHREADS) a.out[i] = v; }
#endif
}
constexpr int NPHASES = 2 + 9 * DEPTH;

extern "C" void kernel_launch(void* const* d_in, const int* in_sizes, int n_in, void* d_out, int out_size, void* d_ws, size_t ws_size, hipStream_t stream) {
    static int grid = 0;
    if (grid == 0) {
        if (n_in != 26 || out_size != M * D || ws_size < 1024 * MiB) { fprintf(stderr, "kernel_launch: unexpected sizes n_in %d out %d ws %zu\n", n_in, out_size, ws_size); grid = -1; return; }
        int dev = 0, cus = 0, per_cu = 0;
        hipGetDevice(&dev); hipDeviceGetAttribute(&cus, hipDeviceAttributeMultiprocessorCount, dev);
        if (hipFuncSetAttribute((const void*)mega, hipFuncAttributeMaxDynamicSharedMemorySize, LDS_BYTES) != hipSuccess) { fprintf(stderr, "kernel_launch: hipFuncSetAttribute failed\n"); grid = -1; return; }
        if (hipOccupancyMaxActiveBlocksPerMultiprocessor(&per_cu, (const void*)mega, NTHREADS, LDS_BYTES) != hipSuccess || per_cu < 1) { fprintf(stderr, "kernel_launch: occupancy query says %d\n", per_cu); per_cu = 1; }
        (void)hipGetLastError();
        grid = cus * 1;
        if (grid <= NSCAN + 8) { fprintf(stderr, "kernel_launch: grid %d too small\n", grid); grid = -1; return; }
    }
    if (grid < 0) return;
    Args a{};
    for (int i = 0; i < 26; ++i) a.in[i] = (const float*)d_in[i];
    a.out = (float*)d_out; a.ws = (unsigned char*)d_ws;
#if MK_MULTI
#if MK_DEBUG
    unsigned* flag = (unsigned*)((unsigned char*)d_ws + WS_FLAG);
    (void)hipMemsetAsync(flag, 0x7f, 4, stream);
    unsigned char* wsb = (unsigned char*)d_ws;
#define DSCAN(off, bytes, is16, code) hipLaunchKernelGGL(dbg_scan, dim3(1024), dim3(512), 0, stream, (const unsigned*)(wsb + (off)), (size_t)(bytes) / 4, is16, flag, code)
#define DSCANX(code) hipLaunchKernelGGL(dbg_scan, dim3(1024), dim3(512), 0, stream, (const unsigned*)d_out, (size_t)M * D, 0, flag, code)
#endif
    for (int p = 0; p < NPHASES; ++p) { a.ph_lo = p; a.ph_hi = p + 1; hipLaunchKernelGGL(mega, dim3(grid), dim3(NTHREADS), LDS_BYTES, stream, a);
#if MK_DEBUG
        const int pp = p < 2 ? p : 2 + (p - 2) % 9;
        const int code = p * 4;
        switch (pp) {
        case 0: DSCAN(WS_MOD, DEPTH * NBATCH * 6144 * 4, 0, code); DSCAN(WS_WIN, WS_P - WS_WIN - MiB / 2, 1, code + 1); break;
        case 1: case 7: case 10: DSCANX(code); DSCAN(WS_XN, (size_t)M * D * 2, 1, code + 1); break;
        case 2: DSCAN(WS_P, (size_t)M * D_IN * 2, 1, code); break;
        case 3: DSCAN(WS_DNC, 320 * MiB, 1, code); DSCAN(WS_QH, 40 * MiB, 1, code + 3); break;
        case 4: hipLaunchKernelGGL(dbg_scan2, dim3(1024), dim3(512), 0, stream, (const unsigned short*)(wsb + WS_XN), M, D, 0, 256, flag, code);
                hipLaunchKernelGGL(dbg_scan2, dim3(1024), dim3(512), 0, stream, (const unsigned short*)(wsb + WS_XN), M, D, 256, 512, flag, code + 1);
                hipLaunchKernelGGL(dbg_scan2, dim3(1024), dim3(512), 0, stream, (const unsigned short*)(wsb + WS_P), M, D_IN, 1536, 512, flag, code + 2);
                hipLaunchKernelGGL(dbg_scan2, dim3(1024), dim3(512), 0, stream, (const unsigned short*)(wsb + WS_XN), M, D, 768, 256, flag, code + 3); break;
        case 5: DSCAN(WS_XN, (size_t)M * D * 2, 1, code); break;
        case 6: case 9: DSCANX(code); break;
        case 8: DSCAN(WS_H, (size_t)M * D_FF * 2, 1, code); break;
        }
#endif
    }
#if MK_DEBUG
    hipLaunchKernelGGL(dbg_fin, dim3(1024), dim3(512), 0, stream, (float*)d_out, (size_t)M * D, flag);
#endif
#else
    a.ph_lo = 0; a.ph_hi = NPHASES;
    (void)hipMemsetAsync((unsigned char*)d_ws + WS_BAR, 0, 16384, stream);
    void* args[] = {&a};
    hipError_t e = hipLaunchCooperativeKernel((const void*)mega, dim3(grid), dim3(NTHREADS), args, LDS_BYTES, stream);
    if (e != hipSuccess) fprintf(stderr, "cooperative launch failed: %s (grid %d)\n", hipGetErrorString(e), grid);
#endif
}
```
